# Optimizing an MI355X kernel written in HIP

```python
import jax, jax.numpy as jnp
from jax import lax
import numpy as np

D_MODEL = 1024
BATCH = 4
SEQ = 8192
DEPTH = 2

GRID_W = 64
CTX_LEN = 256
NORM_EPS = 1e-6
F32 = jnp.float32

D_CONV = 512
D_RWKV = 512
RWKV_HEAD = 64
RWKV_HEADS = D_RWKV // RWKV_HEAD
RWKV_DECAY_RANK = 64
RWKV_ICLR_RANK = 64
RWKV_GATE_RANK = 128
RWKV_LN_EPS = 64e-5
D_NAT = 512
NAT_HEAD = 64
NAT_HEADS = D_NAT // NAT_HEAD
NAT_ROWS = 8
NAT_COLS = 16
GLA_HEADS = 4
GLA_DK = 64
GLA_DV = 128
D_GLA_K = GLA_HEADS * GLA_DK
D_GLA_V = GLA_HEADS * GLA_DV
GLA_GATE_RANK = 16
GLA_GATE_TEMP = 16.0
GLA_CHUNK = 64
ROPE_BASE = 10000.0
N_EXPERTS = 16
D_EXPERT = 1536
EC_CAPACITY_FACTOR = 2

EVEN_SPLIT = [D_CONV, D_CONV, D_CONV, D_RWKV, D_RWKV, D_RWKV, RWKV_DECAY_RANK, RWKV_ICLR_RANK, RWKV_GATE_RANK]
ODD_SPLIT = [D_NAT, D_NAT, D_NAT, D_GLA_K, D_GLA_K, D_GLA_V, D_GLA_V, GLA_GATE_RANK]
EVEN_IN = sum(EVEN_SPLIT)
ODD_IN = sum(ODD_SPLIT)

kernel_name = 'hybrid_diffusion_conv_rwkv7_natten_gla_ecmoe'


def _split(p, sizes):
    return jnp.split(p, np.cumsum(sizes)[:-1].tolist(), axis=-1)


def rmsnorm(x, g, eps=NORM_EPS):
    xf = x.astype(F32)
    y = xf * lax.rsqrt(jnp.mean(xf * xf, axis=-1, keepdims=True) + eps)
    return (y * g.astype(F32)).astype(x.dtype)


def modulate(x, g, shift, scale):
    return rmsnorm(x, g) * (1 + scale) + shift


def conv3(u, w):
    up = jnp.pad(u, ((0, 0), (1, 1), (0, 0)))
    return up[:, :-2] * w[0] + up[:, 1:-1] * w[1] + up[:, 2:] * w[2]


def rope_2d(x):
    L, d = x.shape[1], x.shape[-1]
    half, nf = d // 2, d // 4
    t = jnp.arange(L)
    inv = ROPE_BASE ** (-jnp.arange(nf, dtype=F32) / nf)

    def rot(u, pos):
        ang = pos.astype(F32)[:, None] * inv[None, :]
        cos, sin = jnp.cos(ang)[None, :, None, :], jnp.sin(ang)[None, :, None, :]
        u1, u2 = u[..., :nf].astype(F32), u[..., nf:].astype(F32)
        return jnp.concatenate([u1 * cos - u2 * sin, u1 * sin + u2 * cos], axis=-1)

    return jnp.concatenate([rot(x[..., :half], t // GRID_W), rot(x[..., half:], t % GRID_W)], axis=-1).astype(x.dtype)


def ec_moe(h, router, w1, w3, w2):
    B, T, D = h.shape
    cap = EC_CAPACITY_FACTOR * T // N_EXPERTS
    aff = jax.nn.softmax((h @ router).astype(F32), axis=-1)
    gate, idx = lax.top_k(jnp.swapaxes(aff, 1, 2), cap)
    xin = jax.vmap(lambda hb, ib: hb[ib])(h, idx)
    hid = jax.nn.silu(jnp.einsum('becd,edf->becf', xin, w1)) * jnp.einsum('becd,edf->becf', xin, w3)
    y = jnp.einsum('becf,efd->becd', hid, w2) * gate[..., None].astype(h.dtype)
    out = jax.vmap(lambda ib, yb: jnp.zeros((T, D), yb.dtype).at[ib.reshape(-1)].add(yb.reshape(-1, D)))(idx, y)
    return out.astype(h.dtype)


def rwkv_scan(r, w, k, v, kk, a, S0, reverse, emit):
    xs = tuple(jnp.moveaxis(t, 1, 0) for t in (r, w, k, v, kk, a))

    def step(S, inp):
        rt, wt, kt, vt, kkt, at = inp
        sa = jnp.einsum('bhij,bhj->bhi', S, -kkt)
        S = S * wt[:, :, None, :] + sa[..., None] * (kkt * at)[:, :, None, :] + vt[..., :, None] * kt[:, :, None, :]
        if emit:
            return S, jnp.einsum('bhij,bhj->bhi', S, rt)
        return S, None

    S, ys = lax.scan(step, S0, xs, reverse=reverse)
    return (jnp.moveaxis(ys, 0, 1) if emit else None), S


def rwkv_readout(y, r, k, v, xg, r_k, g_up, ln_g, ln_b):
    B, L = r.shape[:2]
    hs = lambda t: t.reshape(B, L, RWKV_HEADS, RWKV_HEAD)
    yf = y.astype(F32)
    mu = jnp.mean(yf, axis=-1, keepdims=True)
    var = jnp.mean(jnp.square(yf - mu), axis=-1, keepdims=True)
    yn = ((yf - mu) * lax.rsqrt(var + RWKV_LN_EPS)).reshape(B, L, D_RWKV) * ln_g + ln_b
    bonus = (jnp.sum(hs(r) * hs(k) * r_k, axis=-1, keepdims=True) * hs(v)).reshape(B, L, D_RWKV)
    g = jax.nn.sigmoid(xg) @ g_up
    return ((yn + bonus) * g).astype(r.dtype)


def even_mixer(h_lat, h_ctx, w_in, w_out, conv_w, k_k, k_a, r_k, w0, w_up, a0, a_up, g_up, ln_g, ln_b, need_ctx):
    B = h_lat.shape[0]
    p_lat = _split(h_lat @ w_in, EVEN_SPLIT)
    p_ctx = _split(h_ctx @ w_in, EVEN_SPLIT)

    def conv_branch(u, gate_b, gate_c):
        return gate_b * conv3(gate_c * u, conv_w)

    def dir_inputs(r, k, v, xw, xa, d):
        Bq, L = r.shape[:2]
        hs = lambda t: t.reshape(Bq, L, RWKV_HEADS, RWKV_HEAD)
        w_raw = (w0[d] + jnp.tanh(xw) @ w_up[d]).astype(F32)
        decay = jnp.exp(-jnp.exp(-jax.nn.softplus(-w_raw) - 0.5))
        a = jax.nn.sigmoid(a0[d] + xa @ a_up[d])
        kkf = hs((k * k_k).astype(F32))
        kk = kkf * lax.rsqrt(jnp.sum(kkf * kkf, axis=-1, keepdims=True) + 1e-12)
        k_eff = k * (1 + (a - 1) * k_a)
        return hs(r), hs(decay), hs(k_eff), hs(v), kk, hs(a)

    S0 = jnp.zeros((B, RWKV_HEADS, RWKV_HEAD, RWKV_HEAD), F32)
    y_lat, y_ctx = 0.0, 0.0
    for d, rev in ((0, False), (1, True)):
        yc, Sc = rwkv_scan(*dir_inputs(*p_ctx[3:8], d), S0, rev, need_ctx)
        yl, _ = rwkv_scan(*dir_inputs(*p_lat[3:8], d), Sc, rev, True)
        y_lat = y_lat + yl
        if need_ctx:
            y_ctx = y_ctx + yc
    out_lat = jnp.concatenate([conv_branch(*p_lat[0:3]),
                               rwkv_readout(y_lat, *p_lat[3:6], p_lat[8], r_k, g_up, ln_g, ln_b)], axis=-1) @ w_out
    out_ctx = None
    if need_ctx:
        out_ctx = jnp.concatenate([conv_branch(*p_ctx[0:3]),
                                   rwkv_readout(y_ctx, *p_ctx[3:6], p_ctx[8], r_k, g_up, ln_g, ln_b)], axis=-1) @ w_out
    return out_lat, out_ctx


def nat_latent(q, k, v, kc, vc, rpb):
    B, H, L, dh = q.shape
    rows = L // GRID_W
    kr = min(NAT_ROWS, rows)
    kw = NAT_COLS
    qg = q.reshape(B, H, rows, GRID_W, dh)
    kg = k.reshape(B, H, rows, GRID_W, dh)
    vg = v.reshape(B, H, rows, GRID_W, dh)
    col = jnp.arange(GRID_W)
    col_idx = jnp.clip(col - kw // 2, 0, GRID_W - kw)[:, None] + jnp.arange(kw)[None, :]
    col_bias_idx = col_idx - col[:, None] + (NAT_COLS - 1)
    scale = dh ** -0.5

    def row_block(r):
        rs = jnp.clip(r - kr // 2, 0, rows - kr)
        q_r = lax.dynamic_index_in_dim(qg, r, axis=2, keepdims=False)
        k_r = lax.dynamic_slice_in_dim(kg, rs, kr, axis=2)
        v_r = lax.dynamic_slice_in_dim(vg, rs, kr, axis=2)
        k_w = k_r[:, :, :, col_idx]
        v_w = v_r[:, :, :, col_idx]
        row_bias_idx = rs + jnp.arange(kr) - r + (NAT_ROWS - 1)
        bias = rpb[:, row_bias_idx[None, :, None], col_bias_idx[:, None, :]]
        s_loc = jnp.einsum('bhqd,bhrqwd->bhqrw', q_r, k_w) * scale + bias
        s_ctx = jnp.einsum('bhqd,bhcd->bhqc', q_r, kc) * scale
        s = jnp.concatenate([s_loc.reshape(B, H, GRID_W, kr * kw), s_ctx], axis=-1).astype(F32)
        p = jax.nn.softmax(s, axis=-1).astype(v.dtype)
        p_loc = p[..., :kr * kw].reshape(B, H, GRID_W, kr, kw)
        p_ctx = p[..., kr * kw:]
        return jnp.einsum('bhqrw,bhrqwd->bhqd', p_loc, v_w) + jnp.einsum('bhqc,bhcd->bhqd', p_ctx, vc)

    out = lax.map(row_block, jnp.arange(rows))
    return jnp.moveaxis(out, 0, 2).reshape(B, H, L, dh)


def ctx_attention(q, k, v):
    s = jnp.einsum('bhqd,bhkd->bhqk', q, k).astype(F32) * (q.shape[-1] ** -0.5)
    p = jax.nn.softmax(s, axis=-1).astype(v.dtype)
    return jnp.einsum('bhqk,bhkd->bhqd', p, v)


def gla_chunked(q, k, v, logg, S0, emit):
    B, L, H, dk = q.shape
    dv = v.shape[-1]
    C = GLA_CHUNK
    n = L // C
    to_chunks = lambda t: jnp.moveaxis(t.reshape(B, n, C, H, t.shape[-1]), 1, 0)
    xs = tuple(to_chunks(t) for t in (q, k, v, logg))
    mask = jnp.tril(jnp.ones((C, C), bool))[None, :, :, None, None]

    def step(S, inp):
        qc, kc, vc, gc = inp
        b = jnp.cumsum(gc.astype(F32), axis=1)
        bC = b[:, -1]
        S_new = S * jnp.exp(bC)[..., None] + jnp.einsum('bjhd,bjhv->bhdv', kc * jnp.exp(bC[:, None] - b), vc)
        if not emit:
            return S_new, None
        decay = jnp.exp(jnp.where(mask, b[:, :, None] - b[:, None, :], -jnp.inf))
        A = jnp.einsum('bihd,bjhd,bijhd->bhij', qc, kc, decay)
        o = jnp.einsum('bhij,bjhv->bihv', A, vc) + jnp.einsum('bihd,bhdv->bihv', qc * jnp.exp(b), S)
        return S_new, o

    S, ys = lax.scan(step, S0, xs)
    o = jnp.moveaxis(ys, 0, 1).reshape(B, L, H, dv) if emit else None
    return o, S


def gla_log_gate(ga, a_up_d, a_b_d):
    B, L = ga.shape[:2]
    lg = jax.nn.log_sigmoid((ga @ a_up_d + a_b_d).astype(F32)) / GLA_GATE_TEMP
    return lg.reshape(B, L, GLA_HEADS, GLA_DK)


def gla_readout(o, gr, ln_g):
    B, L = gr.shape[:2]
    return (rmsnorm(o, ln_g).reshape(B, L, D_GLA_V) * jax.nn.silu(gr)).astype(gr.dtype)


def odd_mixer(h_lat, h_ctx, w_in, w_out, qn_g, kn_g, rpb, a_up, a_b, gla_ln_g, need_ctx):
    B, L = h_lat.shape[:2]
    Lc = h_ctx.shape[1]
    nq, nk, nv, gq, gk, gv, gr, ga = _split(h_lat @ w_in, ODD_SPLIT)
    cnq, cnk, cnv, cgq, cgk, cgv, cgr, cga = _split(h_ctx @ w_in, ODD_SPLIT)

    def nat_heads(t, g=None):
        t = t.reshape(t.shape[0], t.shape[1], NAT_HEADS, NAT_HEAD)
        if g is not None:
            t = rmsnorm(t, g)
        return jnp.swapaxes(t, 1, 2)

    kc, vc = nat_heads(cnk, kn_g), nat_heads(cnv)
    nat_lat = nat_latent(nat_heads(nq, qn_g), nat_heads(nk, kn_g), nat_heads(nv), kc, vc, rpb)
    nat_lat = jnp.swapaxes(nat_lat, 1, 2).reshape(B, L, D_NAT)

    gh = lambda t, d: t.reshape(t.shape[0], t.shape[1], GLA_HEADS, d)
    qscale = GLA_DK ** -0.5
    q = rope_2d(gh(gq, GLA_DK)) * qscale
    k = rope_2d(gh(gk, GLA_DK))
    v = gh(gv, GLA_DV)
    qc, kcg, vcg = gh(cgq, GLA_DK) * qscale, gh(cgk, GLA_DK), gh(cgv, GLA_DV)
    S0 = jnp.zeros((B, GLA_HEADS, GLA_DK, GLA_DV), F32)
    o_lat, o_ctx = 0.0, 0.0
    for d in range(2):
        f = (lambda t: t) if d == 0 else (lambda t: jnp.flip(t, axis=1))
        oc, Sc = gla_chunked(f(qc), f(kcg), f(vcg), f(gla_log_gate(cga, a_up[d], a_b[d])), S0, need_ctx)
        ol, _ = gla_chunked(f(q), f(k), f(v), f(gla_log_gate(ga, a_up[d], a_b[d])), Sc, True)
        o_lat = o_lat + f(ol)
        if need_ctx:
            o_ctx = o_ctx + f(oc)
    out_lat = jnp.concatenate([nat_lat, gla_readout(o_lat, gr, gla_ln_g)], axis=-1) @ w_out
    out_ctx = None
    if need_ctx:
        nat_ctx = jnp.swapaxes(ctx_attention(nat_heads(cnq, qn_g), kc, vc), 1, 2).reshape(B, Lc, D_NAT)
        out_ctx = jnp.concatenate([nat_ctx, gla_readout(o_ctx, cgr, gla_ln_g)], axis=-1) @ w_out
    return out_lat, out_ctx


def setup_inputs(seed: int = 0) -> dict:
    key = jax.random.key(seed)
    keys = iter(jax.random.split(key, 48))
    ne, no = (DEPTH + 1) // 2, DEPTH // 2

    def normal(shape, std):
        return std * jax.random.normal(next(keys), shape, F32)

    def lin(shape, fan_in, gain=1.0):
        return normal(shape, gain * fan_in ** -0.5)

    def gain(shape):
        return 1.0 + normal(shape, 0.02)

    return {
        'x': normal((BATCH, SEQ, D_MODEL), 1.0),
        'c': normal((BATCH, D_MODEL), 1.0),
        'ctx': normal((BATCH, CTX_LEN, D_MODEL), 1.0),
        'c_ctx': normal((D_MODEL,), 1.0),
        'ada_w': lin((DEPTH, D_MODEL, 6 * D_MODEL), D_MODEL, 0.5),
        'ada_b': normal((DEPTH, 6 * D_MODEL), 0.02),
        'norm1_g': gain((DEPTH, D_MODEL)),
        'norm2_g': gain((DEPTH, D_MODEL)),
        'ev_w_in': lin((ne, D_MODEL, EVEN_IN), D_MODEL),
        'ev_w_out': lin((ne, D_MODEL, D_MODEL), D_MODEL),
        'conv_w': lin((ne, 3, D_CONV), 3),
        'rw_k_k': 0.85 + normal((ne, D_RWKV), 0.02),
        'rw_k_a': gain((ne, D_RWKV)),
        'rw_r_k': normal((ne, RWKV_HEADS, RWKV_HEAD), 0.1),
        'rw_w0': normal((ne, 2, D_RWKV), 1.0),
        'rw_w_up': lin((ne, 2, RWKV_DECAY_RANK, D_RWKV), RWKV_DECAY_RANK, 0.5),
        'rw_a0': normal((ne, 2, D_RWKV), 0.5),
        'rw_a_up': lin((ne, 2, RWKV_ICLR_RANK, D_RWKV), RWKV_ICLR_RANK, 0.5),
        'rw_g_up': lin((ne, RWKV_GATE_RANK, D_RWKV), RWKV_GATE_RANK),
        'rw_ln_g': gain((ne, D_RWKV)),
        'rw_ln_b': normal((ne, D_RWKV), 0.02),
        'od_w_in': lin((no, D_MODEL, ODD_IN), D_MODEL),
        'od_w_out': lin((no, D_MODEL, D_MODEL), D_MODEL),
        'nat_qn_g': gain((no, NAT_HEAD)),
        'nat_kn_g': gain((no, NAT_HEAD)),
        'nat_rpb': normal((no, NAT_HEADS, 2 * NAT_ROWS - 1, 2 * NAT_COLS - 1), 0.1),
        'gla_a_up': lin((no, 2, GLA_GATE_RANK, D_GLA_K), GLA_GATE_RANK),
        'gla_a_b': normal((no, 2, D_GLA_K), 0.5),
        'gla_ln_g': gain((no, GLA_DV)),
        'moe_router': lin((DEPTH, D_MODEL, N_EXPERTS), D_MODEL),
        'moe_w1': lin((DEPTH, N_EXPERTS, D_MODEL, D_EXPERT), D_MODEL),
        'moe_w3': lin((DEPTH, N_EXPERTS, D_MODEL, D_EXPERT), D_MODEL),
        'moe_w2': lin((DEPTH, N_EXPERTS, D_EXPERT, D_MODEL), D_EXPERT),
    }


def reference(x, c, ctx, c_ctx, ada_w, ada_b, norm1_g, norm2_g,
              ev_w_in, ev_w_out, conv_w, rw_k_k, rw_k_a, rw_r_k, rw_w0, rw_w_up, rw_a0, rw_a_up, rw_g_up,
              rw_ln_g, rw_ln_b, od_w_in, od_w_out, nat_qn_g, nat_kn_g, nat_rpb, gla_a_up, gla_a_b, gla_ln_g,
              moe_router, moe_w1, moe_w3, moe_w2):
    ctx_s = ctx
    silu_c = jax.nn.silu(c)
    silu_cc = jax.nn.silu(c_ctx)
    for l in range(DEPTH):
        last = l == DEPTH - 1
        j = l // 2
        sh1, sc1, gt1, sh2, sc2, gt2 = _split((silu_c @ ada_w[l] + ada_b[l])[:, None, :], [D_MODEL] * 6)
        csh1, csc1, cgt1, csh2, csc2, cgt2 = _split(silu_cc @ ada_w[l] + ada_b[l], [D_MODEL] * 6)
        h_lat = modulate(x, norm1_g[l], sh1, sc1)
        h_ctx = modulate(ctx_s, norm1_g[l], csh1, csc1)
        if l % 2 == 0:
            y_lat, y_ctx = even_mixer(h_lat, h_ctx, ev_w_in[j], ev_w_out[j], conv_w[j], rw_k_k[j], rw_k_a[j], rw_r_k[j],
                                      rw_w0[j], rw_w_up[j], rw_a0[j], rw_a_up[j], rw_g_up[j], rw_ln_g[j], rw_ln_b[j],
                                      not last)
        else:
            y_lat, y_ctx = odd_mixer(h_lat, h_ctx, od_w_in[j], od_w_out[j], nat_qn_g[j], nat_kn_g[j], nat_rpb[j],
                                     gla_a_up[j], gla_a_b[j], gla_ln_g[j], not last)
        x = x + gt1 * y_lat
        x = x + gt2 * ec_moe(modulate(x, norm2_g[l], sh2, sc2), moe_router[l], moe_w1[l], moe_w3[l], moe_w2[l])
        if not last:
            ctx_s = ctx_s + cgt1 * y_ctx
            ctx_s = ctx_s + cgt2 * ec_moe(modulate(ctx_s, norm2_g[l], csh2, csc2),
                                          moe_router[l], moe_w1[l], moe_w3[l], moe_w2[l])
    return x
```

```cpp
#include <hip/hip_runtime.h>
#include <hip/hip_cooperative_groups.h>
#include <cstdio>
#include <cstdint>
namespace cg = cooperative_groups;

#ifndef MK_MULTI
#define MK_MULTI 1
#endif
#ifndef MK_XCDBAR
#define MK_XCDBAR 0
#endif

#define LAS __attribute__((address_space(3)))
#define GAS __attribute__((address_space(1)))
typedef unsigned short bf16;
typedef short bf16x8 __attribute__((ext_vector_type(8)));
typedef float f32x4 __attribute__((ext_vector_type(4)));
typedef float f32x2 __attribute__((ext_vector_type(2)));
typedef float f32x16 __attribute__((ext_vector_type(16)));
typedef unsigned u32x4 __attribute__((ext_vector_type(4)));
typedef unsigned u32x2 __attribute__((ext_vector_type(2)));

constexpr int D = 1024, NB = 4, SEQ = 8192, CTXL = 256;
constexpr int ML = NB * SEQ;
constexpr int MC = NB * CTXL;
constexpr int MT = ML + MC;
constexpr int NIN = 3328;
constexpr int ODD_IN = 3088;
constexpr int NQ2 = 2560;
constexpr int NE = 16, DE = 1536;
constexpr int RPE0 = 4352, RPE1 = 4096;
constexpr int NTHREADS = 512, NWAVES = 8;

constexpr size_t MiB = 1u << 20;
constexpr size_t WS_CTL = 0, CTL_ZERO_BYTES = 64 * 1024;
constexpr size_t WS_MOD = 1 * MiB;
constexpr size_t WS_BIAS2 = WS_MOD + 256 * 1024;
constexpr size_t WS_ROPE = WS_BIAS2 + 16 * 1024;
constexpr size_t WS_WB2T = 2 * MiB;
constexpr size_t WS_WIN0 = 4 * MiB, WS_WIN1 = 11 * MiB;
constexpr size_t WS_WOUT0 = 18 * MiB, WS_WOUT1 = 20 * MiB;
constexpr size_t WS_XC = 22 * MiB;
constexpr size_t WS_AFF = 26 * MiB;
constexpr size_t WS_INV = 29 * MiB;
constexpr size_t WS_IDX = 32 * MiB;
constexpr size_t WS_W13T = 33 * MiB;
constexpr size_t WS_W2T = 129 * MiB;
constexpr size_t WS_ACT = 177 * MiB;
constexpr size_t WS_Y0 = 243 * MiB, WS_Y1 = 276 * MiB;
constexpr size_t WS_P = 309 * MiB;
constexpr size_t WS_Q2 = 524 * MiB;
constexpr size_t WS_END = 689 * MiB;
constexpr size_t WS_QF = WS_W13T;
constexpr size_t WS_KF = WS_W13T + 32 * MiB;
constexpr size_t WS_VF = WS_W13T + 65 * MiB;
constexpr size_t GT_TILE = 64 * 64 * 2;
constexpr size_t WS_GQD = WS_Q2;
constexpr size_t WS_GKI = WS_Q2 + 33 * MiB;
constexpr size_t WS_GKS = WS_Q2 + 66 * MiB;
constexpr size_t WS_GVT = WS_Q2 + 99 * MiB;
constexpr size_t WS_GDEC = WS_Q2 + 132 * MiB;

constexpr int RING_BYTES = 131072;
constexpr int MISC_OFF = RING_BYTES;
constexpr int LDS_BYTES = RING_BYTES + 1024;

__device__ __forceinline__ float bflo(unsigned u) { return __uint_as_float(u << 16); }
__device__ __forceinline__ float bfhi(unsigned u) { return __uint_as_float(u & 0xffff0000u); }
__device__ __forceinline__ float bf2f(bf16 h) { return __uint_as_float(((unsigned)h) << 16); }
__device__ __forceinline__ unsigned f2bf(float f) { unsigned u = __float_as_uint(f); return (u + 0x7fffu + ((u >> 16) & 1u)) >> 16; }
__device__ __forceinline__ unsigned pk2(float lo, float hi) { return f2bf(lo) | (f2bf(hi) << 16); }
__device__ __forceinline__ float sigmoidf_(float x) { return 1.0f / (1.0f + __expf(-x)); }
__device__ __forceinline__ float wave_sum(float v) {
#pragma unroll
    for (int o = 1; o < 64; o <<= 1) v += __shfl_xor(v, o);
    return v;
}
template <int CTRL> __device__ __forceinline__ float dpp_f(float v) { return __builtin_bit_cast(float, __builtin_amdgcn_update_dpp(0, __builtin_bit_cast(int, v), CTRL, 0xf, 0xf, false)); }
__device__ __forceinline__ float row16_sum(float v) {
    v += dpp_f<0x128>(v); v += dpp_f<0x124>(v); v += dpp_f<0x122>(v); v += dpp_f<0x121>(v); return v;
}
__device__ __forceinline__ int sample_of(int m) { return m < ML ? (m >> 13) : 4; }

namespace pg8 {
constexpr int BM = 256, BK = 64, HALF = 128, HTB = HALF * BK * 2, STAGE_BYTES = 8 * HTB, NXCD = 8, WGM = 8;
__host__ __device__ __forceinline__ int lds_byte(int r, int c) { const int st = (r >> 4) * 2 + (c >> 5), rr = r & 15, cc = c & 31, ob = rr * 64 + cc * 2; return st * 1024 + (ob ^ (((ob >> 9) & 1) << 5)); }
__host__ __device__ __forceinline__ void stage_rc(int b, int& R, int& C) { const int st = b / 1024, sb = b % 1024, swz = sb ^ (((sb >> 9) & 1) << 5); R = (st >> 1) * 16 + swz / 64; C = (st & 1) * 32 + (swz % 64) / 2; }
__host__ __device__ __forceinline__ int perm32(int rho) { const int n = rho >> 4, i = rho & 15; return 8 * (i >> 2) + 4 * n + (i & 3); }

struct Unit { int pm, pn; };
struct Gemm { const bf16* A; const bf16* Bt; int lda, ldb, K, tpg; size_t bgs; };

struct StaticOrder {
    int nM, nN, nwg, G, c;
    __host__ __device__ void init(int nM_, int nN_, int G_, int c_) { nM = nM_; nN = nN_; nwg = nM * nN; G = G_; c = c_; }
    __host__ __device__ bool next(int i, Unit& u) const {
        const long L = (long)i * G + c; if (L >= nwg) return false;
        int wgid = (int)L; { const int q = nwg / NXCD, r = nwg % NXCD, xcd = wgid % NXCD, off = wgid / NXCD; wgid = (xcd < r ? xcd * (q + 1) : r * (q + 1) + (xcd - r) * q) + off; }
        const int nig = WGM * nN, gid = wgid / nig, fm = gid * WGM, gsz = (nM - fm) < WGM ? (nM - fm) : WGM;
        u.pm = fm + ((wgid % nig) % gsz); u.pn = (wgid % nig) / gsz; return true;
    }
};

template <class Epi>
__device__ __forceinline__ void gemm_phase(LAS unsigned char* lds, const Gemm g, const StaticOrder& S, const Epi& E) {
    const int tid = threadIdx.x, wid = __builtin_amdgcn_readfirstlane(tid >> 6), lane = tid & 63, wr = wid >> 2, wc = wid & 3, fr = lane & 15, fq = lane >> 4;
    const int nt = g.K / BK;
    unsigned voffA[2], voffB[2];
#pragma unroll
    for (int i = 0; i < 2; ++i) { int R, C; stage_rc(tid * 16 + i * 8192, R, C); const int Rb = Epi::PERM ? ((R & ~31) + perm32(R & 31)) : R;
        voffA[i] = (unsigned)(R * g.lda + C) * 2u; voffB[i] = (unsigned)(Rb * g.ldb + C) * 2u; }
    const size_t kstep = (size_t)(BK * 2);
    const size_t hA = (size_t)HALF * g.lda * 2, hB = (size_t)HALF * g.ldb * 2;
    const size_t tA = 2 * hA, tB = 2 * hB;
    const unsigned ldsw = (unsigned)wid * 1024u;
    const int aoff = lds_byte(wr * 64 + fr, fq * 8), boff = lds_byte(wc * 32 + fr, fq * 8);
#define PG8_SA(b, h) (((b) * 2 + (h)) * HTB)
#define PG8_SB(b, h) ((4 + (b) * 2 + (h)) * HTB)
#define PG8_STAGE(bufoff, gbase, voff) do { _Pragma("unroll") for (int _i = 0; _i < 2; ++_i) \
        __builtin_amdgcn_global_load_lds((const unsigned*)((const char*)(gbase) + (voff)[_i]), (LAS unsigned*)(lds + (bufoff) + ldsw + _i * 8192), 16, 0, 0); } while (0)
#define PG8_LDA(dst, b, h) do { _Pragma("unroll") for (int m = 0; m < 4; ++m) _Pragma("unroll") for (int k = 0; k < 2; ++k) dst[m][k] = *(const LAS bf16x8*)(lds + PG8_SA(b, h) + aoff + m * 2048 + k * 1024); } while (0)
#define PG8_LDB(dst, b, h) do { _Pragma("unroll") for (int n = 0; n < 2; ++n) _Pragma("unroll") for (int k = 0; k < 2; ++k) dst[n][k] = *(const LAS bf16x8*)(lds + PG8_SB(b, h) + boff + n * 2048 + k * 1024); } while (0)
#define PG8_MMA(ai, bj, At, Bt) do { __builtin_amdgcn_s_setprio(1); _Pragma("unroll") for (int m = 0; m < 4; ++m) _Pragma("unroll") for (int n = 0; n < 2; ++n) _Pragma("unroll") for (int k = 0; k < 2; ++k) \
        acc[ai][bj][m][n] = __builtin_amdgcn_mfma_f32_16x16x32_bf16(Bt[n][k], At[m][k], acc[ai][bj][m][n], 0, 0, 0); __builtin_amdgcn_s_setprio(0); } while (0)
#define PG8_WAIT_V(n) asm volatile("s_waitcnt vmcnt(" #n ")" ::: "memory")
#define PG8_WAIT_L(n) asm volatile("s_waitcnt lgkmcnt(" #n ")" ::: "memory")
#define PG8_BAR __builtin_amdgcn_s_barrier()
#define PG8_SCHED __builtin_amdgcn_sched_barrier(0)
#define PG8_APTR(u) ((const char*)g.A + (size_t)(u).pm * tA)
#define PG8_BPTR(u) ((const char*)g.Bt + ((size_t)((u).pm / g.tpg) * g.bgs) * 2 + (size_t)(u).pn * tB)
    Unit cur, nxt; int ui = 0;
    if (!S.next(0, cur)) return;
    f32x4 acc[2][2][4][2];
#pragma unroll
    for (int a = 0; a < 2; ++a)
#pragma unroll
        for (int b = 0; b < 2; ++b)
#pragma unroll
            for (int m = 0; m < 4; ++m)
#pragma unroll
                for (int n = 0; n < 2; ++n) acc[a][b][m][n] = (f32x4){0.f, 0.f, 0.f, 0.f};
    bf16x8 At[4][2], B0[2][2], B1[2][2];
    const char* cA = PG8_APTR(cur); const char* cB = PG8_BPTR(cur);
    PG8_STAGE(PG8_SB(0, 0), cB, voffB); PG8_STAGE(PG8_SA(0, 0), cA, voffA); PG8_STAGE(PG8_SB(0, 1), cB + hB, voffB); PG8_STAGE(PG8_SA(0, 1), cA + hA, voffA);
    if (wr == 1) PG8_BAR;
    PG8_WAIT_V(4); PG8_BAR;
    PG8_STAGE(PG8_SB(1, 0), cB + kstep, voffB); PG8_STAGE(PG8_SA(1, 0), cA + kstep, voffA); PG8_STAGE(PG8_SB(1, 1), cB + hB + kstep, voffB);
    PG8_WAIT_V(6); PG8_BAR;
    for (;;) {
        const bool has_next = S.next(ui + 1, nxt);
        const char* nA = has_next ? PG8_APTR(nxt) : cA; const char* nB = has_next ? PG8_BPTR(nxt) : cB;
        for (int t = 0; t < nt; t += 2) {
            const bool last = (t == nt - 2);
            const char* a1 = cA + (size_t)(t + 1) * kstep;
            const char* a2 = last ? nA : cA + (size_t)(t + 2) * kstep; const char* b2 = last ? nB : cB + (size_t)(t + 2) * kstep;
            const char* a3 = a2 + kstep; const char* b3 = b2 + kstep;
            PG8_LDB(B0, 0, 0); PG8_SCHED; PG8_LDA(At, 0, 0); PG8_STAGE(PG8_SA(1, 1), a1 + hA, voffA);
            PG8_WAIT_L(8); PG8_BAR; PG8_WAIT_L(0); PG8_MMA(0, 0, At, B0); PG8_BAR; PG8_SCHED;
            PG8_LDB(B1, 0, 1); PG8_STAGE(PG8_SB(0, 0), b2, voffB);
            PG8_BAR; PG8_WAIT_L(0); PG8_MMA(0, 1, At, B1); PG8_BAR;
            PG8_LDA(At, 0, 1); PG8_STAGE(PG8_SA(0, 0), a2, voffA);
            PG8_BAR; PG8_WAIT_L(0); PG8_MMA(1, 0, At, B0); PG8_BAR; PG8_SCHED;
            PG8_STAGE(PG8_SB(0, 1), b2 + hB, voffB);
            PG8_WAIT_V(6); PG8_BAR; PG8_MMA(1, 1, At, B1); PG8_BAR;
            PG8_LDB(B0, 1, 0); PG8_SCHED; PG8_LDA(At, 1, 0); PG8_STAGE(PG8_SA(0, 1), a2 + hA, voffA);
            PG8_WAIT_L(8); PG8_BAR; PG8_WAIT_L(0); PG8_MMA(0, 0, At, B0); PG8_BAR; PG8_SCHED;
            PG8_LDB(B1, 1, 1); PG8_STAGE(PG8_SB(1, 0), b3, voffB);
            PG8_BAR; PG8_WAIT_L(0); PG8_MMA(0, 1, At, B1); PG8_BAR;
            PG8_LDA(At, 1, 1); PG8_STAGE(PG8_SA(1, 0), a3, voffA);
            PG8_BAR; PG8_WAIT_L(0); PG8_MMA(1, 0, At, B0); PG8_BAR; PG8_SCHED;
            PG8_STAGE(PG8_SB(1, 1), b3 + hB, voffB);
            PG8_WAIT_V(6); PG8_BAR; PG8_MMA(1, 1, At, B1); PG8_BAR;
        }
        E(acc, cur, wr, wc, fr, fq);
        if (!has_next) break;
#pragma unroll
        for (int a = 0; a < 2; ++a)
#pragma unroll
            for (int b = 0; b < 2; ++b)
#pragma unroll
                for (int m = 0; m < 4; ++m)
#pragma unroll
                    for (int n = 0; n < 2; ++n) acc[a][b][m][n] = (f32x4){0.f, 0.f, 0.f, 0.f};
        cur = nxt; cA = nA; cB = nB; ++ui;
    }
    PG8_WAIT_V(0);
    if (wr == 0) PG8_BAR;
    PG8_BAR;
#undef PG8_SA
#undef PG8_SB
#undef PG8_STAGE
#undef PG8_LDA
#undef PG8_LDB
#undef PG8_MMA
#undef PG8_WAIT_V
#undef PG8_WAIT_L
#undef PG8_BAR
#undef PG8_SCHED
#undef PG8_APTR
#undef PG8_BPTR
}

template <int MODE> struct EpiBf16 {
    static constexpr bool PERM = true;
    bf16* O; int ldc; const float* bias;
    __device__ __forceinline__ void operator()(const f32x4 (&acc)[2][2][4][2], const Unit& u, int wr, int wc, int fr, int fq) const {
        const int row0 = u.pm * BM + wr * 64 + fr; const int col0 = u.pn * BM + wc * 32 + 8 * fq;
#pragma unroll
        for (int bj = 0; bj < 2; ++bj) {
            f32x4 b0 = (f32x4){0.f, 0.f, 0.f, 0.f}, b1 = b0;
            if (MODE == 2) { b0 = *(const f32x4*)(bias + col0 + bj * HALF); b1 = *(const f32x4*)(bias + col0 + bj * HALF + 4); }
            int act = 0;
            if (MODE == 1) { if (u.pn == 12) act = (bj == 1) ? 2 : (wc < 2 ? 1 : 0); }
            if (MODE == 2) { act = u.pn < 4 ? 3 : (u.pn < 8 ? 2 : 0); }
#pragma unroll
            for (int ai = 0; ai < 2; ++ai)
#pragma unroll
                for (int m = 0; m < 4; ++m) {
                    f32x4 v0 = acc[ai][bj][m][0] + b0, v1 = acc[ai][bj][m][1] + b1;
                    if (MODE != 0) {
                        if (act == 1) {
#pragma unroll
                            for (int j = 0; j < 4; ++j) { v0[j] = tanhf(v0[j]); v1[j] = tanhf(v1[j]); }
                        } else if (act == 2) {
#pragma unroll
                            for (int j = 0; j < 4; ++j) { v0[j] = sigmoidf_(v0[j]); v1[j] = sigmoidf_(v1[j]); }
                        } else if (act == 3) {
#pragma unroll
                            for (int j = 0; j < 4; ++j) { v0[j] = -0.6065306597f * sigmoidf_(v0[j]); v1[j] = -0.6065306597f * sigmoidf_(v1[j]); }
                        }
                    }
                    u32x4 w; w.x = pk2(v0[0], v0[1]); w.y = pk2(v0[2], v0[3]); w.z = pk2(v1[0], v1[1]); w.w = pk2(v1[2], v1[3]);
                    *(u32x4*)(O + (size_t)(row0 + ai * HALF + m * 16) * ldc + col0 + bj * HALF) = w;
                }
        }
    }
};
struct EpiSwiglu {
    static constexpr bool PERM = true;
    bf16* O; int ldc;
    __device__ __forceinline__ void operator()(const f32x4 (&acc)[2][2][4][2], const Unit& u, int wr, int wc, int fr, int fq) const {
        const int row0 = u.pm * BM + wr * 64 + fr; const int col0 = u.pn * HALF + wc * 32 + 8 * fq;
#pragma unroll
        for (int ai = 0; ai < 2; ++ai)
#pragma unroll
            for (int m = 0; m < 4; ++m) {
                f32x4 v0, v1;
#pragma unroll
                for (int j = 0; j < 4; ++j) { const float a0 = acc[ai][0][m][0][j], a1 = acc[ai][0][m][1][j]; v0[j] = a0 * sigmoidf_(a0) * acc[ai][1][m][0][j]; v1[j] = a1 * sigmoidf_(a1) * acc[ai][1][m][1][j]; }
                u32x4 w; w.x = pk2(v0[0], v0[1]); w.y = pk2(v0[2], v0[3]); w.z = pk2(v1[0], v1[1]); w.w = pk2(v1[2], v1[3]);
                *(u32x4*)(O + (size_t)(row0 + ai * HALF + m * 16) * ldc + col0) = w;
            }
    }
};
struct EpiResid {
    static constexpr bool PERM = false;
    const float* xl; const float* xc; float* ol; float* oc; const float* gate;
    __device__ __forceinline__ void operator()(const f32x4 (&acc)[2][2][4][2], const Unit& u, int wr, int wc, int fr, int fq) const {
        const bool isctx = u.pm >= (ML / BM);
        const int rbase = (isctx ? (u.pm - ML / BM) : u.pm) * BM + wr * 64 + fr; const int col0 = u.pn * BM + wc * 32 + 4 * fq;
        const float* xin = isctx ? xc : xl; float* xo = isctx ? oc : ol;
        const int smp = isctx ? 4 : (u.pm >> 5);
        f32x4 gv[2][2];
#pragma unroll
        for (int bj = 0; bj < 2; ++bj)
#pragma unroll
            for (int n = 0; n < 2; ++n) gv[bj][n] = *(const f32x4*)(gate + smp * 6144 + col0 + bj * HALF + n * 16);
#pragma unroll
        for (int ai = 0; ai < 2; ++ai)
#pragma unroll
            for (int m = 0; m < 4; ++m) { const size_t off = (size_t)(rbase + ai * HALF + m * 16) * D + col0;
#pragma unroll
                for (int bj = 0; bj < 2; ++bj)
#pragma unroll
                    for (int n = 0; n < 2; ++n) { const f32x4 xv = *(const f32x4*)(xin + off + bj * HALF + n * 16); *(f32x4*)(xo + off + bj * HALF + n * 16) = xv + gv[bj][n] * acc[ai][bj][m][n]; }
                asm volatile("" ::: "memory"); }
    }
};
}

#define XB_TMO      128
#define XB_XCNT(j)  (256  + 64 * (j))
#define XB_XSUB(j)  (1280 + 64 * (j))
#define XB_XGEN(j)  (2304 + 64 * (j))
#define XB_TOP      3328
#define XB_TOPGEN   3392
#define XCD_BAR_WORDS 3456
#define XB_SPIN_CAP (1u << 20)
__device__ __forceinline__ unsigned xb_ld(unsigned* p)              { return __hip_atomic_load(p, __ATOMIC_RELAXED, __HIP_MEMORY_SCOPE_AGENT); }
__device__ __forceinline__ unsigned xb_add(unsigned* p, unsigned v) { return __hip_atomic_fetch_add(p, v, __ATOMIC_RELAXED, __HIP_MEMORY_SCOPE_AGENT); }
__device__ __forceinline__ unsigned xb_xcc_id() { return (unsigned)__builtin_amdgcn_s_getreg((3 << 11) | 20) & 0xFu; }
#define XB_SPIN(cond, bar) do { unsigned _sp = 0; while (cond) { __builtin_amdgcn_s_sleep(1); \
    if ((++_sp & 255u) == 0u) { if (xb_ld(&(bar)[XB_TMO])) break; if (_sp > XB_SPIN_CAP) { atomicAdd(&(bar)[XB_TMO], 1u); break; } } } } while (0)
struct XcdBarrier { unsigned* bar; unsigned x; volatile LAS unsigned* st; };
__device__ __forceinline__ XcdBarrier xcd_barrier_post(unsigned* bar, volatile LAS unsigned* st) {
    XcdBarrier b; b.bar = bar; b.x = xb_xcc_id(); b.st = st;
    if (threadIdx.x == 0) (void)xb_add(&bar[XB_XCNT(b.x)], 1u);
    return b;
}
__device__ __forceinline__ void xcd_barrier_complete(unsigned* bar, unsigned x, unsigned& nloc, unsigned& nx) {
    const unsigned G = gridDim.x * gridDim.y * gridDim.z;
    unsigned sum, cnt, mine, sp = 0u;
    for (;;) {
        sum = 0u; cnt = 0u; mine = 0u;
#pragma unroll
        for (unsigned j = 0; j < 16; ++j) { const unsigned c = xb_ld(&bar[XB_XCNT(j)]); sum += c; cnt += (c > 0u) ? 1u : 0u; mine = (j == x) ? c : mine; }
        if (sum == G) break;
        __builtin_amdgcn_s_sleep(1);
        if ((++sp & 255u) == 0u) { if (xb_ld(&bar[XB_TMO])) break; if (sp > XB_SPIN_CAP) { atomicAdd(&bar[XB_TMO], 1u); break; } }
    }
    nloc = mine > 0u ? mine : 1u; nx = cnt > 0u ? cnt : 1u;
}
__device__ __forceinline__ void xcd_barrier(const XcdBarrier& b) {
    asm volatile("s_waitcnt vmcnt(0)" ::: "memory");
    __syncthreads();
    if (threadIdx.x == 0) {
        unsigned* bar = b.bar;
        __builtin_amdgcn_s_waitcnt(0);
        unsigned nloc = b.st[0], nx = b.st[1];
        if (nloc == 0u) { xcd_barrier_complete(bar, b.x, nloc, nx); b.st[0] = nloc; b.st[1] = nx; }
        const unsigned old = xb_add(&bar[XB_XSUB(b.x)], 1u);
        const unsigned gen = old / nloc;
        if (old + 1u == (gen + 1u) * nloc) {
            __builtin_amdgcn_fence(__ATOMIC_RELEASE, "agent");
            asm volatile("s_waitcnt vmcnt(0)" ::: "memory");
            const unsigned og = xb_add(&bar[XB_TOP], 1u);
            const unsigned tg = og / nx;
            if (og + 1u == (tg + 1u) * nx) xb_add(&bar[XB_TOPGEN], 1u);
            else XB_SPIN(xb_ld(&bar[XB_TOPGEN]) == tg, bar);
            __builtin_amdgcn_fence(__ATOMIC_ACQUIRE, "agent");
            xb_add(&bar[XB_XGEN(b.x)], 1u);
            asm volatile("s_waitcnt vmcnt(0)" ::: "memory");
        } else {
            XB_SPIN(xb_ld(&bar[XB_XGEN(b.x)]) == gen, bar);
            __builtin_amdgcn_fence(__ATOMIC_ACQUIRE, "agent");
            asm volatile("s_waitcnt vmcnt(0)" ::: "memory");
        }
    }
    __syncthreads();
}

struct Args { const float* in[33]; float* out; unsigned char* ws; int ph_lo, ph_hi; };
enum { I_X = 0, I_C, I_CTX, I_CCTX, I_ADAW, I_ADAB, I_N1G, I_N2G, I_EVWIN, I_EVWOUT, I_CONVW, I_KK, I_KA, I_RK, I_W0, I_WUP, I_A0, I_AUP, I_GUP, I_LNG, I_LNB,
       I_ODWIN, I_ODWOUT, I_QNG, I_KNG, I_RPB, I_GAUP, I_GAB, I_GLNG, I_ROUTER, I_W1, I_W3, I_W2 };

__device__ __forceinline__ void transpose_item(const float* W, int K, int N, bf16* WT, int ldt, int item, int maptype, LAS float* scr, int lane) {
    const int nblk = (N + 31) / 32, kb = item / nblk, nb = item % nblk, k0 = 64 * kb, n0 = 32 * nb;
    const int drow0 = maptype == 0 ? n0 : ((n0 >> 7) * 256 + (n0 & 127) + (maptype == 2 ? 128 : 0));
    const bool nok = (n0 + (lane & 31)) < N;
#pragma unroll 8
    for (int i = 0; i < 32; ++i) { const int kk = 2 * i + (lane >> 5); scr[kk * 33 + (lane & 31)] = nok ? W[(size_t)(k0 + kk) * N + n0 + (lane & 31)] : 0.f; }
    asm volatile("s_waitcnt lgkmcnt(0)" ::: "memory");
    const int c = lane & 7;
#pragma unroll
    for (int j = 0; j < 4; ++j) { const int n = (lane >> 3) + 8 * j; const LAS float* s = scr + (8 * c) * 33 + n;
        u32x4 o; o.x = pk2(s[0 * 33], s[1 * 33]); o.y = pk2(s[2 * 33], s[3 * 33]); o.z = pk2(s[4 * 33], s[5 * 33]); o.w = pk2(s[6 * 33], s[7 * 33]);
        *(u32x4*)(WT + (size_t)(drow0 + n) * ldt + k0 + 8 * c) = o; }
    asm volatile("s_waitcnt lgkmcnt(0)" ::: "memory");
}
__device__ __forceinline__ void moe_convert(const Args& a, int l, LAS unsigned char* lds, int gw, int NGW, int wave, int lane) {
    LAS float* scr = (LAS float*)(lds + wave * 8448);
    bf16* W13T = (bf16*)(a.ws + WS_W13T); bf16* W2T = (bf16*)(a.ws + WS_W2T);
    for (int it = gw; it < 16 * 2304; it += NGW) {
        const int e = it / 2304, r = it % 2304, which = r / 768, sub = r % 768;
        const size_t wo = ((size_t)l * NE + e) * (size_t)D * DE;
        if (which == 0) transpose_item(a.in[I_W1] + wo, D, DE, W13T + (size_t)e * 3072 * D, D, sub, 1, scr, lane);
        else if (which == 1) transpose_item(a.in[I_W3] + wo, D, DE, W13T + (size_t)e * 3072 * D, D, sub, 2, scr, lane);
        else transpose_item(a.in[I_W2] + wo, DE, D, W2T + (size_t)e * D * DE, DE, sub, 0, scr, lane);
    }
}

__device__ __forceinline__ void ph_prologue(const Args& a, LAS unsigned char* lds, int tid, int wave, int lane) {
    const int G = gridDim.x, bid = blockIdx.x;
    float* mod = (float*)(a.ws + WS_MOD);
    LAS float* fl = (LAS float*)lds;
    for (int item = bid; item < 192; item += G) {
        const int l = item / 96, nb = item % 96;
        for (int i = tid; i < 5 * 1024; i += NTHREADS) { const int s = i >> 10, k = i & 1023; const float v = s < 4 ? a.in[I_C][s * 1024 + k] : a.in[I_CCTX][k]; fl[i] = v / (1.0f + __expf(-v)); }
        __syncthreads();
        const int n = nb * 64 + (tid & 63), kg = tid >> 6;
        const float* W = a.in[I_ADAW] + (size_t)l * D * 6144 + n;
        float s0 = 0.f, s1 = 0.f, s2 = 0.f, s3 = 0.f, s4 = 0.f;
#pragma unroll 8
        for (int k = kg * 128; k < kg * 128 + 128; ++k) { const float w = W[(size_t)k * 6144]; s0 += fl[k] * w; s1 += fl[1024 + k] * w; s2 += fl[2048 + k] * w; s3 += fl[3072 + k] * w; s4 += fl[4096 + k] * w; }
        LAS float* red = fl + 5120;
        red[(kg * 5 + 0) * 64 + (tid & 63)] = s0; red[(kg * 5 + 1) * 64 + (tid & 63)] = s1; red[(kg * 5 + 2) * 64 + (tid & 63)] = s2; red[(kg * 5 + 3) * 64 + (tid & 63)] = s3; red[(kg * 5 + 4) * 64 + (tid & 63)] = s4;
        __syncthreads();
        if (tid < 320) { const int s = tid >> 6, nn = tid & 63; float t = 0.f;
#pragma unroll
            for (int q = 0; q < 8; ++q) t += red[(q * 5 + s) * 64 + nn];
            mod[(l * 5 + s) * 6144 + nb * 64 + nn] = t + a.in[I_ADAB][l * 6144 + nb * 64 + nn]; }
        __syncthreads();
    }
    {
        bf16* WB2T = (bf16*)(a.ws + WS_WB2T); float* bias2 = (float*)(a.ws + WS_BIAS2); float* rope = (float*)(a.ws + WS_ROPE); bf16* WIN1 = (bf16*)(a.ws + WS_WIN1);
        const int gt = bid * NTHREADS + tid, GT = G * NTHREADS;
        for (int i = gt; i < NQ2 * 256; i += GT) {
            const int n = i >> 8, k = i & 255; float v = 0.f;
            if (n < 1024) { if (k < 64) v = a.in[I_WUP][((n >> 9) * 64 + k) * 512 + (n & 511)]; }
            else if (n < 2048) { if (k >= 64 && k < 128) v = a.in[I_AUP][(((n - 1024) >> 9) * 64 + (k - 64)) * 512 + (n & 511)]; }
            else { if (k >= 128) v = a.in[I_GUP][(k - 128) * 512 + (n - 2048)]; }
            WB2T[i] = (bf16)f2bf(v);
        }
        for (int i = gt; i < NQ2; i += GT) bias2[i] = i < 1024 ? a.in[I_W0][i] : (i < 2048 ? a.in[I_A0][i - 1024] : 0.f);
        for (int i = gt; i < 128 * 16; i += GT) { const int pos = i >> 4, f = i & 15; const float inv = powf(10000.0f, -(float)f / 16.0f); const float ang = (float)pos * inv; float sn, cs; sincosf(ang, &sn, &cs); rope[2 * i] = cs; rope[2 * i + 1] = sn; }
        for (int i = gt; i < (NIN - 3104) * D / 8; i += GT) *(u32x4*)(WIN1 + (size_t)3104 * D + (size_t)i * 8) = (u32x4){0u, 0u, 0u, 0u};
    }
    {
        LAS float* scr = (LAS float*)(lds + wave * 8448);
        const int gw = bid * NWAVES + wave, NGW = G * NWAVES;
        __syncthreads();
        for (int it = gw; it < 4240; it += NGW) {
            int r = it;
            if (r < 1664) { transpose_item(a.in[I_EVWIN], D, NIN, (bf16*)(a.ws + WS_WIN0), D, r, 0, scr, lane); continue; } r -= 1664;
            if (r < 512) { transpose_item(a.in[I_EVWOUT], D, D, (bf16*)(a.ws + WS_WOUT0), D, r, 0, scr, lane); continue; } r -= 512;
            if (r < 1552) { transpose_item(a.in[I_ODWIN], D, ODD_IN, (bf16*)(a.ws + WS_WIN1), D, r, 0, scr, lane); continue; } r -= 1552;
            transpose_item(a.in[I_ODWOUT], D, D, (bf16*)(a.ws + WS_WOUT1), D, r, 0, scr, lane);
        }
        moe_convert(a, 0, lds, gw, NGW, wave, lane);
    }
}

__device__ __forceinline__ void norm_mod_store(const f32x4 (&v)[4], float rstd, const float* g, const float* sc, const float* sh, bf16* orow, int lane, f32x4 (&hout)[4]) {
    unsigned long long* o8 = (unsigned long long*)orow + lane;
#pragma unroll
    for (int j = 0; j < 4; ++j) {
        const f32x4 gg = *((const f32x4*)g + lane + 64 * j), s1 = *((const f32x4*)sc + lane + 64 * j), s0 = *((const f32x4*)sh + lane + 64 * j);
        f32x4 h = v[j] * rstd * gg * (s1 + 1.0f) + s0; hout[j] = h;
        o8[64 * j] = (unsigned long long)pk2(h.x, h.y) | ((unsigned long long)pk2(h.z, h.w) << 32);
    }
}
__device__ __forceinline__ float row_rstd(const f32x4 (&v)[4]) {
    float s = 0.f;
#pragma unroll
    for (int j = 0; j < 4; ++j) s += (v[j].x * v[j].x + v[j].y * v[j].y) + (v[j].z * v[j].z + v[j].w * v[j].w);
    return rsqrtf(wave_sum(s) * (1.0f / D) + 1e-6f);
}
__device__ __forceinline__ void ph_norm1_l0(const Args& a, int wave, int lane) {
    const int gw = blockIdx.x * NWAVES + wave, NGW = gridDim.x * NWAVES;
    const float* mod = (const float*)(a.ws + WS_MOD); bf16* ACT = (bf16*)(a.ws + WS_ACT);
    for (int m = gw; m < MT; m += NGW) {
        const float* xr = m < ML ? a.in[I_X] + (size_t)m * D : a.in[I_CTX] + (size_t)(m - ML) * D;
        f32x4 v[4], h[4];
#pragma unroll
        for (int j = 0; j < 4; ++j) v[j] = *((const f32x4*)xr + lane + 64 * j);
        const float rstd = row_rstd(v); const float* ms = mod + (size_t)(0 * 5 + sample_of(m)) * 6144;
        norm_mod_store(v, rstd, a.in[I_N1G], ms + 1024, ms, ACT + (size_t)m * D, lane, h);
    }
}

__device__ __forceinline__ int scan_row(int tau, int b, int d) {
    const bool isctx = tau < CTXL; int t = isctx ? tau : tau - CTXL;
    if (d) t = (isctx ? (CTXL - 1) : (SEQ - 1)) - t;
    return isctx ? (ML + b * CTXL + t) : (b * SEQ + t);
}
__device__ __forceinline__ void ph_rwkv_scan(const Args& a, LAS unsigned char* lds, int tid, int wave, int lane) {
    const bf16* P = (const bf16*)(a.ws + WS_P); const bf16* Q2 = (const bf16*)(a.ws + WS_Q2);
    LAS float* stg = (LAS float*)lds;
    LAS float* ybuf = stg + 2 * 6 * 1024;
    constexpr int NBATCH = (CTXL + SEQ) / 16;
    for (int item = blockIdx.x; item < 128; item += gridDim.x) {
        const int seq = item >> 1, half = item & 1, b = seq >> 4, h = (seq >> 1) & 7, d = seq & 1;
        bf16* Y = (bf16*)(a.ws + (d ? WS_Y1 : WS_Y0));
        const int st = tid >> 5, j0 = 2 * (tid & 31);
        const float kk0 = a.in[I_KK][h * 64 + j0], kk1 = a.in[I_KK][h * 64 + j0 + 1], ka0 = a.in[I_KA][h * 64 + j0], ka1 = a.in[I_KA][h * 64 + j0 + 1];
        const int q = lane & 15, il = wave * 4 + (lane >> 4), irow = half * 32 + il;
        float S0 = 0.f, S1 = 0.f, S2 = 0.f, S3 = 0.f;
        unsigned g_r, g_k, g_v, g_w, g_a;
#define SCAN_LOAD(bi) do { const int m_ = scan_row(16 * (bi) + st, b, d); const bf16* pr_ = P + (size_t)m_ * NIN + h * 64 + j0; const bf16* qr_ = Q2 + (size_t)m_ * NQ2 + d * 512 + h * 64 + j0; \
            g_r = *(const unsigned*)(pr_ + 1536); g_k = *(const unsigned*)(pr_ + 2048); g_v = *(const unsigned*)(pr_ + 2560); g_w = *(const unsigned*)(qr_); g_a = *(const unsigned*)(qr_ + 1024); } while (0)
#define SCAN_STAGE(buf) do { LAS float* B_ = stg + (buf) * 6144 + st * 64 + j0; \
            const float r0 = bflo(g_r), r1 = bfhi(g_r), k0 = bflo(g_k), k1 = bfhi(g_k), v0 = bflo(g_v), v1 = bfhi(g_v), a0 = bflo(g_a), a1 = bfhi(g_a); \
            const float x0 = k0 * kk0, x1 = k1 * kk1; float ss = x0 * x0 + x1 * x1; \
            ss += __shfl_xor(ss, 1); ss += __shfl_xor(ss, 2); ss += __shfl_xor(ss, 4); ss += __shfl_xor(ss, 8); ss += __shfl_xor(ss, 16); \
            const float inv = rsqrtf(ss + 1e-12f); const float n0 = x0 * inv, n1 = x1 * inv; \
            *(LAS f32x2*)(B_ + 0 * 1024) = (f32x2){__expf(bflo(g_w)), __expf(bfhi(g_w))}; \
            *(LAS f32x2*)(B_ + 1 * 1024) = (f32x2){n0, n1}; \
            *(LAS f32x2*)(B_ + 2 * 1024) = (f32x2){n0 * a0, n1 * a1}; \
            *(LAS f32x2*)(B_ + 3 * 1024) = (f32x2){k0 * (1.0f + (a0 - 1.0f) * ka0), k1 * (1.0f + (a1 - 1.0f) * ka1)}; \
            *(LAS f32x2*)(B_ + 4 * 1024) = (f32x2){r0, r1}; \
            *(LAS f32x2*)(B_ + 5 * 1024) = (f32x2){v0, v1}; } while (0)
        __syncthreads();
        SCAN_LOAD(0); SCAN_STAGE(0);
        __syncthreads();
        for (int bi = 0; bi < NBATCH; ++bi) {
            const int cur = bi & 1;
            if (bi + 1 < NBATCH) SCAN_LOAD(bi + 1);
            const LAS float* Bc = stg + cur * 6144;
#pragma unroll
            for (int s = 0; s < 16; ++s) {
                const f32x4 w4 = *(const LAS f32x4*)(Bc + 0 * 1024 + s * 64 + 4 * q), k4 = *(const LAS f32x4*)(Bc + 1 * 1024 + s * 64 + 4 * q), ka4 = *(const LAS f32x4*)(Bc + 2 * 1024 + s * 64 + 4 * q),
                            ke4 = *(const LAS f32x4*)(Bc + 3 * 1024 + s * 64 + 4 * q), r4 = *(const LAS f32x4*)(Bc + 4 * 1024 + s * 64 + 4 * q);
                const float vv = Bc[5 * 1024 + s * 64 + irow];
                float p = (S0 * k4.x + S1 * k4.y) + (S2 * k4.z + S3 * k4.w); p = row16_sum(p);
                const float sa = -p;
                S0 = S0 * w4.x + (sa * ka4.x + vv * ke4.x); S1 = S1 * w4.y + (sa * ka4.y + vv * ke4.y); S2 = S2 * w4.z + (sa * ka4.z + vv * ke4.z); S3 = S3 * w4.w + (sa * ka4.w + vv * ke4.w);
                float yv = (S0 * r4.x + S1 * r4.y) + (S2 * r4.z + S3 * r4.w); yv = row16_sum(yv);
                if (q == 0) ybuf[s * 32 + il] = yv;
            }
            __syncthreads();
            { const int m_ = scan_row(16 * bi + st, b, d); Y[(size_t)m_ * 512 + h * 64 + half * 32 + (tid & 31)] = (bf16)f2bf(ybuf[st * 32 + (tid & 31)]); }
            if (bi + 1 < NBATCH) SCAN_STAGE(cur ^ 1);
            __syncthreads();
        }
#undef SCAN_LOAD
#undef SCAN_STAGE
    }
}

__device__ __forceinline__ void unpack8(const u32x4 u, float (&f)[8]) { f[0] = bflo(u.x); f[1] = bfhi(u.x); f[2] = bflo(u.y); f[3] = bfhi(u.y); f[4] = bflo(u.z); f[5] = bfhi(u.z); f[6] = bflo(u.w); f[7] = bfhi(u.w); }
__device__ __forceinline__ u32x4 pack8(const float (&f)[8]) { u32x4 w; w.x = pk2(f[0], f[1]); w.y = pk2(f[2], f[3]); w.z = pk2(f[4], f[5]); w.w = pk2(f[6], f[7]); return w; }
__device__ __forceinline__ void load8f(const float* p, float (&f)[8]) { const f32x4 a = *(const f32x4*)p, b = *(const f32x4*)(p + 4); f[0] = a.x; f[1] = a.y; f[2] = a.z; f[3] = a.w; f[4] = b.x; f[5] = b.y; f[6] = b.z; f[7] = b.w; }
__device__ __forceinline__ void ph_rwkv_readout(const Args& a, int wave, int lane) {
    const int gw = blockIdx.x * NWAVES + wave, NGW = gridDim.x * NWAVES;
    const bf16* P = (const bf16*)(a.ws + WS_P); const bf16* Q2 = (const bf16*)(a.ws + WS_Q2);
    const bf16* Y0 = (const bf16*)(a.ws + WS_Y0); const bf16* Y1 = (const bf16*)(a.ws + WS_Y1); bf16* ACT = (bf16*)(a.ws + WS_ACT);
    const int c8 = 8 * lane;
    float cw0[8], cw1[8], cw2[8], lng[8], lnb[8], rk[8];
    load8f(a.in[I_CONVW] + c8, cw0); load8f(a.in[I_CONVW] + 512 + c8, cw1); load8f(a.in[I_CONVW] + 1024 + c8, cw2);
    load8f(a.in[I_LNG] + c8, lng); load8f(a.in[I_LNB] + c8, lnb); load8f(a.in[I_RK] + c8, rk);
    for (int m = gw; m < MT; m += NGW) {
        int t, L; if (m < ML) { t = m & (SEQ - 1); L = SEQ; } else { t = (m - ML) & (CTXL - 1); L = CTXL; }
        const bf16* pr = P + (size_t)m * NIN;
        const u32x4 z4 = (u32x4){0u, 0u, 0u, 0u};
        float u[8], gb[8], gc[8], up[8], gcp[8], un[8], gcn[8], o[8];
        unpack8(*(const u32x4*)(pr + c8), u); unpack8(*(const u32x4*)(pr + 512 + c8), gb); unpack8(*(const u32x4*)(pr + 1024 + c8), gc);
        unpack8(t > 0 ? *(const u32x4*)(pr - NIN + c8) : z4, up); unpack8(t > 0 ? *(const u32x4*)(pr - NIN + 1024 + c8) : z4, gcp);
        unpack8(t < L - 1 ? *(const u32x4*)(pr + NIN + c8) : z4, un); unpack8(t < L - 1 ? *(const u32x4*)(pr + NIN + 1024 + c8) : z4, gcn);
#pragma unroll
        for (int i = 0; i < 8; ++i) o[i] = gb[i] * (cw0[i] * (gcp[i] * up[i]) + cw1[i] * (gc[i] * u[i]) + cw2[i] * (gcn[i] * un[i]));
        *(u32x4*)(ACT + (size_t)m * D + c8) = pack8(o);
        float y0[8], y1[8], r[8], k[8], v[8], g[8];
        unpack8(*(const u32x4*)(Y0 + (size_t)m * 512 + c8), y0); unpack8(*(const u32x4*)(Y1 + (size_t)m * 512 + c8), y1);
        unpack8(*(const u32x4*)(pr + 1536 + c8), r); unpack8(*(const u32x4*)(pr + 2048 + c8), k); unpack8(*(const u32x4*)(pr + 2560 + c8), v);
        unpack8(*(const u32x4*)(Q2 + (size_t)m * NQ2 + 2048 + c8), g);
        float s = 0.f, bs = 0.f;
#pragma unroll
        for (int i = 0; i < 8; ++i) { y0[i] += y1[i]; s += y0[i]; bs += r[i] * k[i] * rk[i]; }
        s += __shfl_xor(s, 1); s += __shfl_xor(s, 2); s += __shfl_xor(s, 4);
        bs += __shfl_xor(bs, 1); bs += __shfl_xor(bs, 2); bs += __shfl_xor(bs, 4);
        const float mu = s * (1.0f / 64.0f); float q = 0.f;
#pragma unroll
        for (int i = 0; i < 8; ++i) { y0[i] -= mu; q += y0[i] * y0[i]; }
        q += __shfl_xor(q, 1); q += __shfl_xor(q, 2); q += __shfl_xor(q, 4);
        const float rstd = rsqrtf(q * (1.0f / 64.0f) + 64e-5f);
#pragma unroll
        for (int i = 0; i < 8; ++i) o[i] = (y0[i] * rstd * lng[i] + lnb[i] + bs * v[i]) * g[i];
        *(u32x4*)(ACT + (size_t)m * D + 512 + c8) = pack8(o);
    }
}

__device__ __forceinline__ void ph_norm2_router(const Args& a, int l, int Mrows, LAS unsigned char* lds, int tid, int wave, int lane) {
    LAS float* rtT = (LAS float*)lds;
    const float* R = a.in[I_ROUTER] + (size_t)l * D * 16;
    __syncthreads();
    for (int i = tid; i < D * 16; i += NTHREADS) { const int c = i >> 4, e = i & 15; rtT[e * 1024 + c] = R[i]; }
    __syncthreads();
    const int gw = blockIdx.x * NWAVES + wave, NGW = gridDim.x * NWAVES;
    const float* mod = (const float*)(a.ws + WS_MOD); bf16* ACT = (bf16*)(a.ws + WS_ACT); float* AFF = (float*)(a.ws + WS_AFF);
    const float* XC = (const float*)(a.ws + WS_XC);
    for (int m = gw; m < Mrows; m += NGW) {
        const float* xr = m < ML ? a.out + (size_t)m * D : XC + (size_t)(m - ML) * D;
        f32x4 v[4], h[4];
#pragma unroll
        for (int j = 0; j < 4; ++j) v[j] = *((const f32x4*)xr + lane + 64 * j);
        const float rstd = row_rstd(v); const float* ms = mod + (size_t)(l * 5 + sample_of(m)) * 6144;
        norm_mod_store(v, rstd, a.in[I_N2G] + l * D, ms + 4096, ms + 3072, ACT + (size_t)m * D, lane, h);
        float mine = -1e30f;
#pragma unroll 2
        for (int e = 0; e < 16; ++e) { float acc = 0.f;
#pragma unroll
            for (int j = 0; j < 4; ++j) { const f32x4 rv = *(const LAS f32x4*)(rtT + e * 1024 + 4 * lane + 256 * j); acc += (h[j].x * rv.x + h[j].y * rv.y) + (h[j].z * rv.z + h[j].w * rv.w); }
            acc = wave_sum(acc); mine = (lane == e) ? acc : mine; }
        float mx = mine;
        mx = fmaxf(mx, __shfl_xor(mx, 1)); mx = fmaxf(mx, __shfl_xor(mx, 2)); mx = fmaxf(mx, __shfl_xor(mx, 4)); mx = fmaxf(mx, __shfl_xor(mx, 8));
        const float ex = lane < 16 ? __expf(mine - mx) : 0.f;
        float den = ex; den += __shfl_xor(den, 1); den += __shfl_xor(den, 2); den += __shfl_xor(den, 4); den += __shfl_xor(den, 8);
        mine = ex / den;
        if (lane < 16) AFF[(size_t)m * 16 + lane] = mine;
    }
}

__device__ __forceinline__ int block_excl_scan(int v, LAS int* tmp, int wave, int lane, int& total) {
    int inc = v;
#pragma unroll
    for (int o = 1; o < 64; o <<= 1) { const int t = __shfl_up(inc, o); if (lane >= o) inc += t; }
    if (lane == 63) tmp[wave] = inc;
    __syncthreads();
    int base = 0, tot = 0;
#pragma unroll
    for (int w = 0; w < NWAVES; ++w) { const int x = tmp[w]; if (w < wave) base += x; tot += x; }
    __syncthreads();
    total = tot; return base + inc - v;
}
__device__ __forceinline__ void ph_topk(const Args& a, int l, LAS unsigned char* lds, int tid, int wave, int lane) {
    LAS unsigned* keys = (LAS unsigned*)lds;
    LAS int* hist = (LAS int*)(lds + 32768);
    LAS int* sfx = hist + 256;
    LAS int* tmp = sfx + 264;
    LAS int* bc = tmp + 8;
    const float* AFF = (const float*)(a.ws + WS_AFF); int* INV = (int*)(a.ws + WS_INV); int* IDX = (int*)(a.ws + WS_IDX);
    const int nitems = l == 0 ? 128 : 64, RPE = l == 0 ? RPE0 : RPE1;
    for (int item = blockIdx.x; item < nitems; item += gridDim.x) {
        const bool lat = item < 64; const int b = (item & 63) >> 4, e = item & 15;
        const int T = lat ? SEQ : CTXL, cap = T / 8, row0 = lat ? b * SEQ : ML + b * CTXL, segbase = lat ? b * 1024 : 4096 + b * 32;
        __syncthreads();
        for (int i = tid; i < T; i += NTHREADS) keys[i] = __float_as_uint(AFF[(size_t)(row0 + i) * 16 + e]);
        unsigned prefix = 0u, mask = 0u; int kk = cap;
        for (int pass = 0; pass < 4; ++pass) {
            const int shift = 24 - 8 * pass;
            if (tid < 256) hist[tid] = 0;
            __syncthreads();
            for (int i = tid; i < T; i += NTHREADS) { const unsigned k = keys[i]; if ((k & mask) == prefix) __hip_atomic_fetch_add(&hist[(k >> shift) & 255u], 1, __ATOMIC_RELAXED, __HIP_MEMORY_SCOPE_WORKGROUP); }
            __syncthreads();
            if (tid < 256) { int s = 0; for (int q = tid; q < 256; ++q) s += hist[q]; sfx[tid] = s; } else if (tid == 256) sfx[256] = 0;
            __syncthreads();
            if (tid < 256) { const int s0 = sfx[tid], s1 = sfx[tid + 1]; if (s0 >= kk && s1 < kk) { bc[0] = tid; bc[1] = kk - s1; } }
            __syncthreads();
            prefix |= ((unsigned)bc[0]) << shift; mask |= 0xffu << shift; kk = bc[1];
            __syncthreads();
        }
        const unsigned thr = prefix; const int need = kk;
        const int i0 = 16 * tid; int ceq = 0;
        unsigned kv[16];
#pragma unroll
        for (int i = 0; i < 16; ++i) { kv[i] = (i0 + i < T) ? keys[i0 + i] : 0u; ceq += (i0 + i < T && kv[i] == thr) ? 1 : 0; }
        int tot; int eqr = block_excl_scan(ceq, tmp, wave, lane, tot);
        int nsel = 0; unsigned selmask = 0u;
#pragma unroll
        for (int i = 0; i < 16; ++i) { bool sel = false; if (i0 + i < T) { if (kv[i] > thr) sel = true; else if (kv[i] == thr) { sel = eqr < need; ++eqr; } } if (sel) { selmask |= 1u << i; ++nsel; } }
        int slot = segbase + block_excl_scan(nsel, tmp, wave, lane, tot);
#pragma unroll
        for (int i = 0; i < 16; ++i) if (i0 + i < T) { const int row = row0 + i0 + i; if (selmask & (1u << i)) { IDX[e * RPE + slot] = row; INV[(size_t)row * 16 + e] = slot; ++slot; } else INV[(size_t)row * 16 + e] = -1; }
        if (l == 0 && lat && b == 0 && tid < 128) IDX[e * RPE + 4224 + tid] = 0;
    }
}

__device__ __forceinline__ void ph_gather(const Args& a, int l, int wave, int lane) {
    const int gw = blockIdx.x * NWAVES + wave, NGW = gridDim.x * NWAVES;
    const bf16* ACT = (const bf16*)(a.ws + WS_ACT); bf16* XIN = (bf16*)(a.ws + WS_Q2); const int* IDX = (const int*)(a.ws + WS_IDX);
    const int nrows = 16 * (l == 0 ? RPE0 : RPE1);
    for (int r = gw; r < nrows; r += NGW) {
        const int src = IDX[r];
        const u32x4* s = (const u32x4*)(ACT + (size_t)src * D) + lane; u32x4* d = (u32x4*)(XIN + (size_t)r * D) + lane;
        const u32x4 x0 = s[0], x1 = s[64]; d[0] = x0; d[64] = x1;
    }
}

template <bool NEXTNORM>
__device__ __forceinline__ void ph_combine(const Args& a, int l, int Mrows, int wave, int lane) {
    const int gw = blockIdx.x * NWAVES + wave, NGW = gridDim.x * NWAVES;
    const float* mod = (const float*)(a.ws + WS_MOD); bf16* ACT = (bf16*)(a.ws + WS_ACT); const float* AFF = (const float*)(a.ws + WS_AFF);
    const int* INV = (const int*)(a.ws + WS_INV); const bf16* YE = (const bf16*)(a.ws + WS_Q2); float* XC = (float*)(a.ws + WS_XC);
    const int RPE = l == 0 ? RPE0 : RPE1;
    for (int m = gw; m < Mrows; m += NGW) {
        float* xr = m < ML ? a.out + (size_t)m * D : XC + (size_t)(m - ML) * D;
        const int smp = sample_of(m); const float* ms = mod + (size_t)(l * 5 + smp) * 6144;
        f32x4 acc[4];
#pragma unroll
        for (int j = 0; j < 4; ++j) acc[j] = (f32x4){0.f, 0.f, 0.f, 0.f};
        const int myinv = lane < 16 ? INV[(size_t)m * 16 + lane] : -1; const float myaff = lane < 16 ? AFF[(size_t)m * 16 + lane] : 0.f;
        for (int e = 0; e < 16; ++e) {
            const int slot = __shfl(myinv, e); const float gt = __shfl(myaff, e);
            if (slot >= 0) {
                const unsigned long long* yr = (const unsigned long long*)(YE + ((size_t)e * RPE + slot) * D) + lane;
#pragma unroll
                for (int j = 0; j < 4; ++j) { const unsigned long long w = yr[64 * j]; const unsigned lo = (unsigned)w, hi = (unsigned)(w >> 32);
                    acc[j].x += gt * bflo(lo); acc[j].y += gt * bfhi(lo); acc[j].z += gt * bflo(hi); acc[j].w += gt * bfhi(hi); }
            }
        }
        f32x4 v[4], h[4];
#pragma unroll
        for (int j = 0; j < 4; ++j) { const f32x4 g2 = *((const f32x4*)(ms + 5120) + lane + 64 * j); v[j] = *((const f32x4*)xr + lane + 64 * j) + g2 * acc[j]; *((f32x4*)xr + lane + 64 * j) = v[j]; }
        if (NEXTNORM) {
            const float rstd = row_rstd(v); const float* ms1 = mod + (size_t)(1 * 5 + smp) * 6144;
            norm_mod_store(v, rstd, a.in[I_N1G] + D, ms1 + 1024, ms1, ACT + (size_t)m * D, lane, h);
        }
    }
}

__device__ __forceinline__ f32x4 mfma16(bf16x8 a, bf16x8 b, f32x4 c) { return __builtin_amdgcn_mfma_f32_16x16x32_bf16(a, b, c, 0, 0, 0); }
__device__ __forceinline__ f32x16 mfma32(bf16x8 a, bf16x8 b, f32x16 c) { return __builtin_amdgcn_mfma_f32_32x32x16_bf16(a, b, c, 0, 0, 0); }
__device__ __forceinline__ float logsigmoidf_(float x) { return fminf(x, 0.f) - log1pf(__expf(-fabsf(x))); }

__device__ __forceinline__ void ph_l1_prep(const Args& a, LAS unsigned char* lds, int tid, int wave, int lane) {
    const bf16* P = (const bf16*)(a.ws + WS_P);
    const int G = gridDim.x, bid = blockIdx.x;
    {
        bf16* QF = (bf16*)(a.ws + WS_QF); bf16* KF = (bf16*)(a.ws + WS_KF); bf16* VF = (bf16*)(a.ws + WS_VF);
        const int gw = bid * NWAVES + wave, NGW = G * NWAVES;
        const int tok = lane & 31, hf = lane >> 5;
        for (int it = gw; it < 1056 * 8; it += NGW) {
            const int tc = it >> 3, h = it & 7;
            const bool lat = tc < 1024; const int b = lat ? (tc >> 8) : ((tc - 1024) >> 3), kc = lat ? (tc & 255) : (256 + ((tc - 1024) & 7));
            const size_t m = (size_t)32 * tc + tok;
#pragma unroll
            for (int which = 0; which < 2; ++which) {
                if (which == 1 && !lat) break;
                const bf16* src = P + m * NIN + (which == 0 ? 512 : 0) + h * 64 + 32 * hf;
                const float* gn = a.in[which == 0 ? I_KNG : I_QNG] + 32 * hf;
                float f[4][8]; float ss = 0.f;
#pragma unroll
                for (int e = 0; e < 4; ++e) { unpack8(*(const u32x4*)(src + 8 * e), f[e]);
#pragma unroll
                    for (int i = 0; i < 8; ++i) ss += f[e][i] * f[e][i]; }
                ss += __shfl_xor(ss, 32);
                const float rstd = rsqrtf(ss * (1.0f / 64.0f) + 1e-6f) * (which == 1 ? 0.125f : 1.0f);
                bf16* dst = which == 0 ? KF + ((size_t)((b * 8 + h) * 264 + kc) * 4) * 512 : QF + ((size_t)((b * 8 + h) * 256 + kc) * 4) * 512;
#pragma unroll
                for (int e = 0; e < 4; ++e) { float o[8];
#pragma unroll
                    for (int i = 0; i < 8; ++i) o[i] = f[e][i] * rstd * gn[8 * e + i];
                    const int s = 2 * hf + (e >> 1), hp = e & 1;
                    *(u32x4*)(dst + ((size_t)s * 64 + tok + 32 * hp) * 8) = pack8(o); }
            }
            bf16* vdst = VF + ((size_t)((b * 8 + h) * 264 + kc) * 4) * 512;
#pragma unroll
            for (int mt = 0; mt < 2; ++mt)
#pragma unroll
                for (int s = 0; s < 2; ++s) { float o[8];
#pragma unroll
                    for (int j = 0; j < 8; ++j) { const int tk = 16 * s + 8 * (j >> 2) + 4 * hf + (j & 3); o[j] = bf2f(P[((size_t)32 * tc + tk) * NIN + 1024 + h * 64 + 32 * mt + tok]); }
                    *(u32x4*)(vdst + ((size_t)(mt * 2 + s) * 64 + lane) * 8) = pack8(o); }
        }
    }
    {
        LAS float* ga = (LAS float*)lds;
        LAS float* bcum = ga + 1024;
        LAS float* tot = bcum + 64 * 256;
        bf16* GQD = (bf16*)(a.ws + WS_GQD); bf16* GKI = (bf16*)(a.ws + WS_GKI); bf16* GKS = (bf16*)(a.ws + WS_GKS); bf16* GVT = (bf16*)(a.ws + WS_GVT);
        float* GDEC = (float*)(a.ws + WS_GDEC); const float* rope = (const float*)(a.ws + WS_ROPE);
        for (int item = bid; item < 528 * 2; item += G) {
            const int cg = item >> 1, d = item & 1; const bool lat = cg < 512;
            __syncthreads();
            { const int i = tid >> 3, r2 = (tid & 7) * 2; const unsigned w = *(const unsigned*)(P + ((size_t)64 * cg + i) * NIN + 3072 + r2); ga[i * 16 + r2] = bflo(w); ga[i * 16 + r2 + 1] = bfhi(w); }
            __syncthreads();
            { const int c = tid & 255, hf = tid >> 8; float au[16];
#pragma unroll
                for (int r = 0; r < 16; ++r) au[r] = a.in[I_GAUP][(d * 16 + r) * 256 + c];
                const float ab = a.in[I_GAB][d * 256 + c]; float run = 0.f;
                for (int ii = 0; ii < 32; ++ii) { const int i = d == 0 ? 32 * hf + ii : 32 * hf + 31 - ii; float x = ab;
#pragma unroll
                    for (int r = 0; r < 16; ++r) x += ga[i * 16 + r] * au[r];
                    run += logsigmoidf_(x) * (1.0f / 16.0f); bcum[i * 256 + c] = run; }
                tot[hf * 256 + c] = run; }
            __syncthreads();
            for (int idx = tid; idx < 64 * 128; idx += NTHREADS) {
                const int i = idx >> 7, rem = idx & 127, h = rem >> 5, pp = rem & 31, part = pp >> 4, f = pp & 15, j1 = 32 * part + f, j2 = j1 + 16;
                const size_t m = (size_t)64 * cg + i; const bf16* pr = P + m * NIN + h * 64;
                float q1 = bf2f(pr[1536 + j1]), q2 = bf2f(pr[1536 + j2]), k1 = bf2f(pr[1792 + j1]), k2 = bf2f(pr[1792 + j2]);
                if (lat) { const int t = (int)(m & (SEQ - 1)); const int pos = part == 0 ? (t >> 6) : (t & 63); const float cs = rope[(pos * 16 + f) * 2], sn = rope[(pos * 16 + f) * 2 + 1];
                    const float qa = q1 * cs - q2 * sn, qb = q1 * sn + q2 * cs, ka = k1 * cs - k2 * sn, kb = k1 * sn + k2 * cs; q1 = qa; q2 = qb; k1 = ka; k2 = kb; }
                const int c1 = h * 64 + j1, c2 = h * 64 + j2;
                const bool addoff = d == 0 ? (i >= 32) : (i < 32); const int oh = d == 0 ? 0 : 1;
                const float b1 = bcum[i * 256 + c1] + (addoff ? tot[oh * 256 + c1] : 0.f), b2 = bcum[i * 256 + c2] + (addoff ? tot[oh * 256 + c2] : 0.f);
                const float bC1 = tot[c1] + tot[256 + c1], bC2 = tot[c2] + tot[256 + c2];
                const size_t tb = ((size_t)(cg * 2 + d) * 4 + h) * 4096;
                GQD[tb + i * 64 + j1] = (bf16)f2bf(q1 * 0.125f * __expf(b1)); GQD[tb + i * 64 + j2] = (bf16)f2bf(q2 * 0.125f * __expf(b2));
                GKI[tb + i * 64 + j1] = (bf16)f2bf(k1 * __expf(-b1)); GKI[tb + i * 64 + j2] = (bf16)f2bf(k2 * __expf(-b2));
                GKS[tb + j1 * 64 + i] = (bf16)f2bf(k1 * __expf(bC1 - b1)); GKS[tb + j2 * 64 + i] = (bf16)f2bf(k2 * __expf(bC2 - b2));
            }
            if (tid < 256) GDEC[(size_t)(cg * 2 + d) * 256 + tid] = __expf(tot[tid] + tot[256 + tid]);
            if (d == 0) {
                for (int idx = tid; idx < 512 * 8; idx += NTHREADS) { const int hdv = idx & 511, tg = idx >> 9; float o[8];
#pragma unroll
                    for (int e = 0; e < 8; ++e) o[e] = bf2f(P[((size_t)64 * cg + 8 * tg + e) * NIN + 2048 + hdv]);
                    *(u32x4*)(GVT + ((size_t)cg * 512 + hdv) * 64 + 8 * tg) = pack8(o); }
            }
        }
    }
}

__device__ __forceinline__ void ph_gla_main(const Args& a, LAS unsigned char* lds, int item, int tid, int wave, int lane) {
    constexpr int PT = 72;
    constexpr int BUF = (64 * 3 + 128) * PT * 2 + 256;
    const int b = item >> 3, d = (item >> 2) & 1, h = item & 3;
    const bf16* GQD = (const bf16*)(a.ws + WS_GQD); const bf16* GKI = (const bf16*)(a.ws + WS_GKI); const bf16* GKS = (const bf16*)(a.ws + WS_GKS); const bf16* GVT = (const bf16*)(a.ws + WS_GVT);
    const float* GDEC = (const float*)(a.ws + WS_GDEC); bf16* O = (bf16*)(a.ws + (d ? WS_Y1 : WS_Y0));
    LAS bf16* As = (LAS bf16*)(lds + 2 * BUF); LAS bf16* ST = As + 64 * PT;
    const int lr = lane & 15, lq = lane >> 4;
    for (int i = tid; i < 128 * PT / 2; i += NTHREADS) ((LAS unsigned*)ST)[i] = 0u;
    f32x4 accS[4];
#pragma unroll
    for (int mt = 0; mt < 4; ++mt) accS[mt] = (f32x4){0.f, 0.f, 0.f, 0.f};
    u32x4 pq, pk, ps, pv0, pv1; float pd = 0.f;
#define GLA_CG(n) ((n) < 4 ? 512 + 4 * b + (d == 0 ? (n) : 3 - (n)) : 128 * b + (d == 0 ? (n) - 4 : 127 - ((n) - 4)))
#define GLA_LOAD(n) do { const int cg_ = GLA_CG(n); const size_t tb_ = ((size_t)(cg_ * 2 + d) * 4 + h) * 4096; \
        pq = *((const u32x4*)(GQD + tb_) + tid); pk = *((const u32x4*)(GKI + tb_) + tid); ps = *((const u32x4*)(GKS + tb_) + tid); \
        const u32x4* vt_ = (const u32x4*)(GVT + ((size_t)cg_ * 4 + h) * 8192); pv0 = vt_[tid]; pv1 = vt_[tid + 512]; \
        if (tid < 64) pd = GDEC[(size_t)(cg_ * 2 + d) * 256 + h * 64 + tid]; } while (0)
#define GLA_WRITE(bufi) do { LAS bf16* B_ = (LAS bf16*)(lds + (bufi) * BUF); const int row_ = tid >> 3, c8_ = (tid & 7) * 8; \
        *(LAS u32x4*)(B_ + row_ * PT + c8_) = pq; *(LAS u32x4*)(B_ + 64 * PT + row_ * PT + c8_) = pk; *(LAS u32x4*)(B_ + 128 * PT + row_ * PT + c8_) = ps; \
        *(LAS u32x4*)(B_ + 192 * PT + row_ * PT + c8_) = pv0; *(LAS u32x4*)(B_ + 192 * PT + (row_ + 64) * PT + c8_) = pv1; \
        if (tid < 64) ((LAS float*)(B_ + 320 * PT))[tid] = pd; } while (0)
    GLA_LOAD(0);
    __syncthreads();
    GLA_WRITE(0);
    __syncthreads();
    for (int n = 0; n < 132; ++n) {
        const int cur = n & 1; const int cg = GLA_CG(n); const bool lat = n >= 4;
        if (n + 1 < 132) GLA_LOAD(n + 1);
        const LAS bf16* Qd = (const LAS bf16*)(lds + cur * BUF); const LAS bf16* Ki = Qd + 64 * PT; const LAS bf16* Ks = Qd + 128 * PT; const LAS bf16* VT = Qd + 192 * PT;
        const LAS float* DEC = (const LAS float*)(Qd + 320 * PT);
#pragma unroll
        for (int tt = 0; tt < 2; ++tt) {
            const int tile = 2 * wave + tt, mi = tile >> 2, nj = tile & 3;
            f32x4 acc = (f32x4){0.f, 0.f, 0.f, 0.f};
            const bool dead = d == 0 ? (nj > mi) : (nj < mi);
            if (!dead) {
#pragma unroll
                for (int ks = 0; ks < 2; ++ks) acc = mfma16(*(const LAS bf16x8*)(Qd + (16 * mi + lr) * PT + 32 * ks + 8 * lq), *(const LAS bf16x8*)(Ki + (16 * nj + lr) * PT + 32 * ks + 8 * lq), acc);
            }
#pragma unroll
            for (int rg = 0; rg < 4; ++rg) { const int i = 16 * mi + 4 * lq + rg, j = 16 * nj + lr; const bool keep = d == 0 ? (j <= i) : (j >= i); As[i * PT + j] = (bf16)f2bf(keep ? acc[rg] : 0.f); }
        }
        __syncthreads();
        if (lat) {
#pragma unroll
            for (int mi = 0; mi < 4; ++mi) {
                f32x4 acc = (f32x4){0.f, 0.f, 0.f, 0.f};
#pragma unroll
                for (int ks = 0; ks < 2; ++ks) {
                    acc = mfma16(*(const LAS bf16x8*)(As + (16 * mi + lr) * PT + 32 * ks + 8 * lq), *(const LAS bf16x8*)(VT + (16 * wave + lr) * PT + 32 * ks + 8 * lq), acc);
                    acc = mfma16(*(const LAS bf16x8*)(Qd + (16 * mi + lr) * PT + 32 * ks + 8 * lq), *(const LAS bf16x8*)(ST + (16 * wave + lr) * PT + 32 * ks + 8 * lq), acc);
                }
#pragma unroll
                for (int rg = 0; rg < 4; ++rg) { const size_t m = (size_t)64 * cg + 16 * mi + 4 * lq + rg; O[m * 512 + h * 128 + 16 * wave + lr] = (bf16)f2bf(acc[rg]); }
            }
        }
#pragma unroll
        for (int mt = 0; mt < 4; ++mt) {
#pragma unroll
            for (int rg = 0; rg < 4; ++rg) accS[mt][rg] *= DEC[16 * mt + 4 * lq + rg];
#pragma unroll
            for (int ks = 0; ks < 2; ++ks) accS[mt] = mfma16(*(const LAS bf16x8*)(Ks + (16 * mt + lr) * PT + 32 * ks + 8 * lq), *(const LAS bf16x8*)(VT + (16 * wave + lr) * PT + 32 * ks + 8 * lq), accS[mt]);
            u32x2 w; w.x = pk2(accS[mt][0], accS[mt][1]); w.y = pk2(accS[mt][2], accS[mt][3]);
            *(LAS u32x2*)(ST + (16 * wave + lr) * PT + 16 * mt + 4 * lq) = w;
        }
        if (n + 1 < 132) GLA_WRITE(cur ^ 1);
        __syncthreads();
    }
#undef GLA_CG
#undef GLA_LOAD
#undef GLA_WRITE
}

__device__ __forceinline__ void ph_nat_item(const Args& a, const LAS float* rpb, int item, int lane) {
    const int b = item >> 10, h = (item >> 7) & 7, r = item & 127;
    const bf16x8* QF = (const bf16x8*)(a.ws + WS_QF); const bf16x8* KF = (const bf16x8*)(a.ws + WS_KF); const bf16x8* VF = (const bf16x8*)(a.ws + WS_VF);
    bf16* ACT = (bf16*)(a.ws + WS_ACT);
    const int hf = lane >> 5, ql = lane & 31;
    bf16x8 qf[2][4];
#pragma unroll
    for (int qt = 0; qt < 2; ++qt)
#pragma unroll
        for (int s = 0; s < 4; ++s) qf[qt][s] = QF[((size_t)((b * 8 + h) * 256 + 2 * r + qt) * 4 + s) * 64 + lane];
    const int rs = min(max(r - 4, 0), 120);
    f32x16 Oa[2][2]; float mrun[2], lrun[2];
#pragma unroll
    for (int qt = 0; qt < 2; ++qt) { mrun[qt] = -1e20f; lrun[qt] = 0.f;
#pragma unroll
        for (int mt = 0; mt < 2; ++mt)
#pragma unroll
            for (int i = 0; i < 16; ++i) Oa[qt][mt][i] = 0.f; }
    for (int ch = 0; ch < 24; ++ch) {
        const bool local = ch < 16; const int wi = ch >> 1, hc = ch & 1; const int kc = local ? 2 * (rs + wi) + hc : 256 + (ch - 16);
        const size_t kb = (size_t)((b * 8 + h) * 264 + kc) * 4 * 64;
        bf16x8 kf[4], vf[2][2];
#pragma unroll
        for (int s = 0; s < 4; ++s) kf[s] = KF[kb + s * 64 + lane];
#pragma unroll
        for (int mt = 0; mt < 2; ++mt)
#pragma unroll
            for (int s = 0; s < 2; ++s) vf[mt][s] = VF[kb + (mt * 2 + s) * 64 + lane];
#pragma unroll
        for (int qt = 0; qt < 2; ++qt) {
            f32x16 S;
#pragma unroll
            for (int i = 0; i < 16; ++i) S[i] = 0.f;
#pragma unroll
            for (int s = 0; s < 4; ++s) S = mfma32(kf[s], qf[qt][s], S);
            if (local) {
                const int c = 32 * qt + ql, cs = min(max(c - 8, 0), 48); const LAS float* brow = rpb + (h * 15 + (rs + wi - r + 7)) * 31;
#pragma unroll
                for (int rg = 0; rg < 16; ++rg) { const int kcol = 32 * hc + (rg & 3) + 8 * (rg >> 2) + 4 * hf; const bool valid = kcol >= cs && kcol < cs + 16; const int dc = min(max(kcol - c + 15, 0), 30);
                    S[rg] = valid ? S[rg] + brow[dc] : -1e30f; }
            }
            float mx = S[0];
#pragma unroll
            for (int rg = 1; rg < 16; ++rg) mx = fmaxf(mx, S[rg]);
            mx = fmaxf(mx, __shfl_xor(mx, 32));
            const float mnew = fmaxf(mrun[qt], mx), scale = __expf(mrun[qt] - mnew); mrun[qt] = mnew;
            float ps = 0.f;
#pragma unroll
            for (int rg = 0; rg < 16; ++rg) { S[rg] = __expf(S[rg] - mnew); ps += S[rg]; }
            lrun[qt] = lrun[qt] * scale + ps;
#pragma unroll
            for (int mt = 0; mt < 2; ++mt)
#pragma unroll
                for (int i = 0; i < 16; ++i) Oa[qt][mt][i] *= scale;
            bf16x8 pf[2];
#pragma unroll
            for (int s = 0; s < 2; ++s) { u32x4 w; w.x = pk2(S[8 * s + 0], S[8 * s + 1]); w.y = pk2(S[8 * s + 2], S[8 * s + 3]); w.z = pk2(S[8 * s + 4], S[8 * s + 5]); w.w = pk2(S[8 * s + 6], S[8 * s + 7]); pf[s] = __builtin_bit_cast(bf16x8, w); }
#pragma unroll
            for (int mt = 0; mt < 2; ++mt)
#pragma unroll
                for (int s = 0; s < 2; ++s) Oa[qt][mt] = mfma32(vf[mt][s], pf[s], Oa[qt][mt]);
        }
    }
#pragma unroll
    for (int qt = 0; qt < 2; ++qt) {
        const float l = lrun[qt] + __shfl_xor(lrun[qt], 32); const float inv = 1.0f / l;
        const size_t m = (size_t)b * SEQ + r * 64 + 32 * qt + ql;
#pragma unroll
        for (int mt = 0; mt < 2; ++mt)
#pragma unroll
            for (int g = 0; g < 4; ++g) { u32x2 w; w.x = pk2(Oa[qt][mt][4 * g] * inv, Oa[qt][mt][4 * g + 1] * inv); w.y = pk2(Oa[qt][mt][4 * g + 2] * inv, Oa[qt][mt][4 * g + 3] * inv);
                *(u32x2*)(ACT + m * D + h * 64 + 32 * mt + 8 * g + 4 * hf) = w; }
    }
}
__device__ __forceinline__ void ph_nat_gla(const Args& a, LAS unsigned char* lds, int tid, int wave, int lane) {
    const int G = gridDim.x, bid = blockIdx.x;
    const int ngla = G >= 64 ? 32 : 0;
    if (ngla && bid < 32) { ph_gla_main(a, lds, bid, tid, wave, lane); return; }
    LAS float* rpb = (LAS float*)lds;
    __syncthreads();
    for (int i = tid; i < 8 * 15 * 31; i += NTHREADS) rpb[i] = a.in[I_RPB][i];
    __syncthreads();
    const int gwn = (bid - ngla) * NWAVES + wave, NW = (G - ngla) * NWAVES;
    for (int item = gwn; item < 4096; item += NW) ph_nat_item(a, rpb, item, lane);
    if (!ngla) { __syncthreads(); for (int it = bid; it < 32; it += G) ph_gla_main(a, lds, it, tid, wave, lane); }
}

__device__ __forceinline__ void ph_gla_readout(const Args& a, int wave, int lane) {
    const int gw = blockIdx.x * NWAVES + wave, NGW = gridDim.x * NWAVES;
    const bf16* P = (const bf16*)(a.ws + WS_P); const bf16* O0 = (const bf16*)(a.ws + WS_Y0); const bf16* O1 = (const bf16*)(a.ws + WS_Y1); bf16* ACT = (bf16*)(a.ws + WS_ACT);
    const int c8 = 8 * lane; float lg[8]; load8f(a.in[I_GLNG] + (c8 & 127), lg);
    for (int m = gw; m < ML; m += NGW) {
        float o0[8], o1[8], gr[8], o[8];
        unpack8(*(const u32x4*)(O0 + (size_t)m * 512 + c8), o0); unpack8(*(const u32x4*)(O1 + (size_t)m * 512 + c8), o1); unpack8(*(const u32x4*)(P + (size_t)m * NIN + 2560 + c8), gr);
        float ss = 0.f;
#pragma unroll
        for (int i = 0; i < 8; ++i) { o0[i] += o1[i]; ss += o0[i] * o0[i]; }
        ss += __shfl_xor(ss, 1); ss += __shfl_xor(ss, 2); ss += __shfl_xor(ss, 4); ss += __shfl_xor(ss, 8);
        const float rstd = rsqrtf(ss * (1.0f / 128.0f) + 1e-6f);
#pragma unroll
        for (int i = 0; i < 8; ++i) o[i] = o0[i] * rstd * lg[i] * (gr[i] * sigmoidf_(gr[i]));
        *(u32x4*)(ACT + (size_t)m * D + 512 + c8) = pack8(o);
    }
}

constexpr int NPH = 24;
__global__ void __launch_bounds__(NTHREADS) fwd_megakernel(Args a) {
    extern __shared__ __attribute__((aligned(16))) unsigned char lds_raw[];
    LAS unsigned char* lds = (LAS unsigned char*)lds_raw;
    const int tid = threadIdx.x, lane = tid & 63, wave = __builtin_amdgcn_readfirstlane(tid >> 6);
    const int G = gridDim.x, bid = blockIdx.x;
#if MK_XCDBAR
    volatile LAS unsigned* MISC = (volatile LAS unsigned*)(lds + MISC_OFF);
    if (tid < 64) MISC[tid] = 0u;
    __syncthreads();
    XcdBarrier xbar = xcd_barrier_post((unsigned*)(a.ws + WS_CTL) + 1024, MISC + 8);
#define GRID_BAR() xcd_barrier(xbar)
#else
    cg::grid_group grid = cg::this_grid();
#define GRID_BAR() grid.sync()
#endif
    const int lo = a.ph_lo, hi = a.ph_hi;
#ifdef ONLY_PH
#define IN(k) ((k) == ONLY_PH && lo <= (k) && (k) < hi)
#else
#define IN(k) (lo <= (k) && (k) < hi)
#endif
#define SEAM(k) do { if (IN(k) && IN((k) + 1)) GRID_BAR(); } while (0)
    float* mod = (float*)(a.ws + WS_MOD);
    bf16* ACT = (bf16*)(a.ws + WS_ACT); bf16* P = (bf16*)(a.ws + WS_P); bf16* Q2 = (bf16*)(a.ws + WS_Q2);
    bf16* XIN = (bf16*)(a.ws + WS_Q2); bf16* HID = (bf16*)(a.ws + WS_P); bf16* YE = (bf16*)(a.ws + WS_Q2);
    float* XC = (float*)(a.ws + WS_XC);
    pg8::StaticOrder S;

    if (IN(0)) ph_prologue(a, lds, tid, wave, lane);
    SEAM(0);
    if (IN(1)) ph_norm1_l0(a, wave, lane);
    SEAM(1);
    if (IN(2)) { pg8::Gemm g{ACT, (const bf16*)(a.ws + WS_WIN0), D, D, D, 1 << 30, 0}; S.init(MT / 256, NIN / 256, G, bid);
        pg8::EpiBf16<1> E{P, NIN, nullptr}; pg8::gemm_phase(lds, g, S, E); }
    SEAM(2);
    if (IN(3)) { pg8::Gemm g{P + 3072, (const bf16*)(a.ws + WS_WB2T), NIN, 256, 256, 1 << 30, 0}; S.init(MT / 256, NQ2 / 256, G, bid);
        pg8::EpiBf16<2> E{Q2, NQ2, (const float*)(a.ws + WS_BIAS2)}; pg8::gemm_phase(lds, g, S, E); }
    SEAM(3);
    if (IN(4)) ph_rwkv_scan(a, lds, tid, wave, lane);
    SEAM(4);
    if (IN(5)) ph_rwkv_readout(a, wave, lane);
    SEAM(5);
    if (IN(6)) { pg8::Gemm g{ACT, (const bf16*)(a.ws + WS_WOUT0), D, D, D, 1 << 30, 0}; S.init(MT / 256, D / 256, G, bid);
        pg8::EpiResid E{a.in[I_X], a.in[I_CTX], a.out, XC, mod + 2048}; pg8::gemm_phase(lds, g, S, E); }
    SEAM(6);
    if (IN(7)) ph_norm2_router(a, 0, MT, lds, tid, wave, lane);
    SEAM(7);
    if (IN(8)) ph_topk(a, 0, lds, tid, wave, lane);
    SEAM(8);
    if (IN(9)) ph_gather(a, 0, wave, lane);
    SEAM(9);
    if (IN(10)) { pg8::Gemm g{XIN, (const bf16*)(a.ws + WS_W13T), D, D, D, RPE0 / 256, (size_t)3072 * D}; S.init(NE * RPE0 / 256, 3072 / 256, G, bid);
        pg8::EpiSwiglu E{HID, DE}; pg8::gemm_phase(lds, g, S, E); }
    SEAM(10);
    if (IN(11)) { pg8::Gemm g{HID, (const bf16*)(a.ws + WS_W2T), DE, DE, DE, RPE0 / 256, (size_t)D * DE}; S.init(NE * RPE0 / 256, D / 256, G, bid);
        pg8::EpiBf16<0> E{YE, D, nullptr}; pg8::gemm_phase(lds, g, S, E); }
    SEAM(11);
    if (IN(12)) ph_combine<true>(a, 0, MT, wave, lane);
    SEAM(12);
    if (IN(13)) { pg8::Gemm g{ACT, (const bf16*)(a.ws + WS_WIN1), D, D, D, 1 << 30, 0}; S.init(MT / 256, NIN / 256, G, bid);
        pg8::EpiBf16<0> E{P, NIN, nullptr}; pg8::gemm_phase(lds, g, S, E); }
    SEAM(13);
    if (IN(14)) ph_l1_prep(a, lds, tid, wave, lane);
    SEAM(14);
    if (IN(15)) ph_nat_gla(a, lds, tid, wave, lane);
    SEAM(15);
    if (IN(16)) ph_gla_readout(a, wave, lane);
    SEAM(16);
    if (IN(17)) { pg8::Gemm g{ACT, (const bf16*)(a.ws + WS_WOUT1), D, D, D, 1 << 30, 0}; S.init(ML / 256, D / 256, G, bid);
        pg8::EpiResid E{a.out, XC, a.out, XC, mod + 5 * 6144 + 2048}; pg8::gemm_phase(lds, g, S, E); }
    SEAM(17);
    if (IN(18)) { ph_norm2_router(a, 1, ML, lds, tid, wave, lane); __syncthreads(); moe_convert(a, 1, lds, bid * NWAVES + wave, G * NWAVES, wave, lane); }
    SEAM(18);
    if (IN(19)) ph_topk(a, 1, lds, tid, wave, lane);
    SEAM(19);
    if (IN(20)) ph_gather(a, 1, wave, lane);
    SEAM(20);
    if (IN(21)) { pg8::Gemm g{XIN, (const bf16*)(a.ws + WS_W13T), D, D, D, RPE1 / 256, (size_t)3072 * D}; S.init(NE * RPE1 / 256, 3072 / 256, G, bid);
        pg8::EpiSwiglu E{HID, DE}; pg8::gemm_phase(lds, g, S, E); }
    SEAM(21);
    if (IN(22)) { pg8::Gemm g{HID, (const bf16*)(a.ws + WS_W2T), DE, DE, DE, RPE1 / 256, (size_t)D * DE}; S.init(NE * RPE1 / 256, D / 256, G, bid);
        pg8::EpiBf16<0> E{YE, D, nullptr}; pg8::gemm_phase(lds, g, S, E); }
    SEAM(22);
    if (IN(23)) ph_combine<false>(a, 1, ML, wave, lane);
#undef IN
#undef SEAM
}

extern "C" void kernel_launch(void* const* d_in, const int* in_sizes, int n_in, void* d_out, int out_size, void* d_ws, size_t ws_size, hipStream_t stream) {
    static int grid = 0;
    if (grid == 0) {
        if (n_in != 33 || out_size != ML * D || ws_size < WS_END) { fprintf(stderr, "kernel_launch: unexpected problem (n_in %d, out %d, ws %zu < %zu); nothing launched\n", n_in, out_size, ws_size, (size_t)WS_END); grid = -1; return; }
        int dev = 0, cus = 0, per_cu = 0;
        if (hipGetDevice(&dev) != hipSuccess || hipDeviceGetAttribute(&cus, hipDeviceAttributeMultiprocessorCount, dev) != hipSuccess) { grid = -1; return; }
        if (hipFuncSetAttribute((const void*)fwd_megakernel, hipFuncAttributeMaxDynamicSharedMemorySize, LDS_BYTES) != hipSuccess) { fprintf(stderr, "kernel_launch: hipFuncSetAttribute failed\n"); grid = -1; return; }
        if (hipOccupancyMaxActiveBlocksPerMultiprocessor(&per_cu, (const void*)fwd_megakernel, NTHREADS, LDS_BYTES) != hipSuccess || per_cu < 1) { fprintf(stderr, "kernel_launch: occupancy query says %d blocks per CU\n", per_cu); per_cu = 1; }
        (void)hipGetLastError();
        grid = cus;
    }
    if (grid < 0) return;
    (void)hipMemsetAsync((char*)d_ws + WS_CTL, 0, CTL_ZERO_BYTES, stream);
    Args a{};
    for (int i = 0; i < 33; ++i) a.in[i] = (const float*)d_in[i];
    a.out = (float*)d_out; a.ws = (unsigned char*)d_ws;
#if MK_MULTI
    for (int ph = 0; ph < NPH; ++ph) { a.ph_lo = ph; a.ph_hi = ph + 1; hipLaunchKernelGGL(fwd_megakernel, dim3(grid), dim3(NTHREADS), LDS_BYTES, stream, a); }
#else
    a.ph_lo = 0; a.ph_hi = NPH;
    void* args[] = {&a};
    hipError_t e = hipLaunchCooperativeKernel((const void*)fwd_megakernel, dim3(grid), dim3(NTHREADS), args, LDS_BYTES, stream);
    if (e != hipSuccess) fprintf(stderr, "kernel_launch: cooperative launch failed: %s (grid %d)\n", hipGetErrorString(e), grid);
#endif
}
```

```cpp
#include <hip/hip_runtime.h>
#include <hip/hip_cooperative_groups.h>
#include <cstdio>
#include <cstdint>
namespace cg = cooperative_groups;

#ifndef MK_MULTI
#define MK_MULTI 0
#endif
#ifndef MK_REPEAT_MASK
#define MK_REPEAT_MASK 0u
#endif
#ifndef DBG_REP
#define DBG_REP 0
#endif
#define REPS(k) ((DBG_REP == (k)) ? 2 : 1)
#ifndef MK_XCDBAR
#define MK_XCDBAR 1
#endif

#define LAS __attribute__((address_space(3)))
#define GAS __attribute__((address_space(1)))
typedef unsigned short bf16;
typedef short bf16x8 __attribute__((ext_vector_type(8)));
typedef float f32x4 __attribute__((ext_vector_type(4)));
typedef float f32x2 __attribute__((ext_vector_type(2)));
typedef float f32x16 __attribute__((ext_vector_type(16)));
typedef unsigned u32x4 __attribute__((ext_vector_type(4)));
typedef unsigned u32x2 __attribute__((ext_vector_type(2)));

constexpr int D = 1024, NB = 4, SEQ = 8192, CTXL = 256;
constexpr int ML = NB * SEQ;
constexpr int MC = NB * CTXL;
constexpr int MT = ML + MC;
constexpr int NIN = 3328;
constexpr int ODD_IN = 3088;
constexpr int NQ2 = 2560;
constexpr int NE = 16, DE = 1536;
constexpr int RPE0 = 4352, RPE1 = 4096;
constexpr int NTHREADS = 512, NWAVES = 8;

constexpr size_t MiB = 1u << 20;
constexpr size_t WS_CTL = 0, CTL_ZERO_BYTES = 64 * 1024;
constexpr size_t WS_MOD = 1 * MiB;
constexpr size_t WS_BIAS2 = WS_MOD + 256 * 1024;
constexpr size_t WS_ROPE = WS_BIAS2 + 16 * 1024;
constexpr size_t WS_WB2T = 2 * MiB;
constexpr size_t WS_WIN0 = 4 * MiB, WS_WIN1 = 11 * MiB;
constexpr size_t WS_WOUT0 = 18 * MiB, WS_WOUT1 = 20 * MiB;
constexpr size_t WS_XC = 22 * MiB;
constexpr size_t WS_AFF = 26 * MiB;
constexpr size_t WS_INV = 29 * MiB;
constexpr size_t WS_IDX = 32 * MiB;
constexpr size_t WS_W13T = 33 * MiB;
constexpr size_t WS_W2T = 129 * MiB;
constexpr size_t WS_ACT = 177 * MiB;
constexpr size_t WS_Y0 = 243 * MiB, WS_Y1 = 276 * MiB;
constexpr size_t WS_P = 309 * MiB;
constexpr size_t WS_Q2 = 524 * MiB;
constexpr size_t WS_END = 689 * MiB;
constexpr size_t WS_QF = WS_END;
constexpr size_t WS_KF = WS_END + 32 * MiB;
constexpr size_t WS_VF = WS_END + 65 * MiB;
constexpr size_t WS_NEED = WS_END + 98 * MiB;
constexpr size_t WS_GQD = WS_Q2;
constexpr size_t WS_KLOC = WS_Q2 + 32 * MiB;
constexpr size_t WS_GST = WS_Q2 + 98 * MiB;
constexpr size_t WS_GDEC = WS_Q2 + 162 * MiB;

constexpr int RING_BYTES = 131072;
constexpr int MISC_OFF = RING_BYTES;
constexpr int LDS_BYTES = RING_BYTES + 1024;

__device__ __forceinline__ float bflo(unsigned u) { return __uint_as_float(u << 16); }
__device__ __forceinline__ float bfhi(unsigned u) { return __uint_as_float(u & 0xffff0000u); }
__device__ __forceinline__ float bf2f(bf16 h) { return __uint_as_float(((unsigned)h) << 16); }
typedef __bf16 nbf16x2 __attribute__((ext_vector_type(2)));
__device__ __forceinline__ unsigned pk2(float lo, float hi) { const f32x2 f = {lo, hi}; return __builtin_bit_cast(unsigned, __builtin_convertvector(f, nbf16x2)); }
__device__ __forceinline__ unsigned f2bf(float f) { return pk2(f, f) & 0xffffu; }
__device__ __forceinline__ float sigmoidf_(float x) { return __builtin_amdgcn_rcpf(1.0f + __expf(-x)); }
__device__ __forceinline__ float wave_sum(float v) {
#pragma unroll
    for (int o = 1; o < 64; o <<= 1) v += __shfl_xor(v, o);
    return v;
}
template <int CTRL> __device__ __forceinline__ float dpp_f(float v) { return __builtin_bit_cast(float, __builtin_amdgcn_update_dpp(0, __builtin_bit_cast(int, v), CTRL, 0xf, 0xf, false)); }
__device__ __forceinline__ float row16_sum(float v) {
    v += dpp_f<0x128>(v); v += dpp_f<0x124>(v); v += dpp_f<0x122>(v); v += dpp_f<0x121>(v); return v;
}
__device__ __forceinline__ void unpack8(const u32x4 u, float (&f)[8]) { f[0] = bflo(u.x); f[1] = bfhi(u.x); f[2] = bflo(u.y); f[3] = bfhi(u.y); f[4] = bflo(u.z); f[5] = bfhi(u.z); f[6] = bflo(u.w); f[7] = bfhi(u.w); }
__device__ __forceinline__ u32x4 pack8(const float (&f)[8]) { u32x4 w; w.x = pk2(f[0], f[1]); w.y = pk2(f[2], f[3]); w.z = pk2(f[4], f[5]); w.w = pk2(f[6], f[7]); return w; }
__device__ __forceinline__ void load8f(const float* p, float (&f)[8]) { const f32x4 a = *(const f32x4*)p, b = *(const f32x4*)(p + 4); f[0] = a.x; f[1] = a.y; f[2] = a.z; f[3] = a.w; f[4] = b.x; f[5] = b.y; f[6] = b.z; f[7] = b.w; }
#define LDS_BARRIER() do { asm volatile("s_waitcnt lgkmcnt(0)" ::: "memory"); __builtin_amdgcn_s_barrier(); asm volatile("" ::: "memory"); } while (0)
__device__ __forceinline__ int sample_of(int m) { return m < ML ? (m >> 13) : 4; }

namespace pg8 {
constexpr int BM = 256, BK = 64, HALF = 128, HTB = HALF * BK * 2, STAGE_BYTES = 8 * HTB, NXCD = 8, WGM = 8;
__host__ __device__ __forceinline__ int lds_byte(int r, int c) { const int st = (r >> 4) * 2 + (c >> 5), rr = r & 15, cc = c & 31, ob = rr * 64 + cc * 2; return st * 1024 + (ob ^ (((ob >> 9) & 1) << 5)); }
__host__ __device__ __forceinline__ void stage_rc(int b, int& R, int& C) { const int st = b / 1024, sb = b % 1024, swz = sb ^ (((sb >> 9) & 1) << 5); R = (st >> 1) * 16 + swz / 64; C = (st & 1) * 32 + (swz % 64) / 2; }
__host__ __device__ __forceinline__ int perm32(int rho) { const int n = rho >> 4, i = rho & 15; return 8 * (i >> 2) + 4 * n + (i & 3); }

struct Unit { int pm, pn; };
struct Gemm { const bf16* A; const bf16* Bt; int lda, ldb, K, tpg; size_t bgs; const int* gidx; int halftile; };

struct StaticOrder {
    int nM, nN, nwg, G, c;
    __host__ __device__ void init(int nM_, int nN_, int G_, int c_) { nM = nM_; nN = nN_; nwg = nM * nN; G = G_; c = c_; }
    __host__ __device__ bool next(int i, Unit& u) const {
        const long L = (long)i * G + c; if (L >= nwg) return false;
        int wgid = (int)L; { const int q = nwg / NXCD, r = nwg % NXCD, xcd = wgid % NXCD, off = wgid / NXCD; wgid = (xcd < r ? xcd * (q + 1) : r * (q + 1) + (xcd - r) * q) + off; }
        const int nig = WGM * nN, gid = wgid / nig, fm = gid * WGM, gsz = (nM - fm) < WGM ? (nM - fm) : WGM;
        u.pm = fm + ((wgid % nig) % gsz); u.pn = (wgid % nig) / gsz; return true;
    }
};

template <class Epi, bool GATHER = false>
__device__ __forceinline__ void gemm_phase(LAS unsigned char* lds, const Gemm g, const StaticOrder& S, const Epi& E) {
    const int tid = threadIdx.x, wid = __builtin_amdgcn_readfirstlane(tid >> 6), lane = tid & 63, wr = wid >> 2, wc = wid & 3, fr = lane & 15, fq = lane >> 4;
    const int nt = g.K / BK;
    unsigned voffB[2]; int rA[2], cA2[2];
#pragma unroll
    for (int i = 0; i < 2; ++i) { int R, C; stage_rc(tid * 16 + i * 8192, R, C); const int Rb = Epi::PERM ? ((R & ~31) + perm32(R & 31)) : R;
        rA[i] = R; cA2[i] = C * 2; voffB[i] = (unsigned)(Rb * g.ldb + C) * 2u; }
    const size_t kstep = (size_t)(BK * 2);
    const size_t hA = (size_t)HALF * g.lda * 2, hB = (size_t)HALF * g.ldb * 2;
    const size_t tA = 2 * hA, tB = 2 * hB;
    const unsigned ldsw = (unsigned)wid * 1024u;
    const int aoff = lds_byte(wr * 64 + fr, fq * 8), boff = lds_byte(wc * 32 + fr, fq * 8);
#define PG8_SA(b, h) (((b) * 2 + (h)) * HTB)
#define PG8_SB(b, h) ((4 + (b) * 2 + (h)) * HTB)
#define PG8_STAGE(bufoff, gbase, voff) do { _Pragma("unroll") for (int _i = 0; _i < 2; ++_i) \
        __builtin_amdgcn_global_load_lds((const unsigned*)((const char*)(gbase) + (voff)[_i]), (LAS unsigned*)(lds + (bufoff) + ldsw + _i * 8192), 16, 0, 0); } while (0)
#define PG8_LDA(dst, b, h) do { _Pragma("unroll") for (int m = 0; m < 4; ++m) _Pragma("unroll") for (int k = 0; k < 2; ++k) dst[m][k] = *(const LAS bf16x8*)(lds + PG8_SA(b, h) + aoff + m * 2048 + k * 1024); } while (0)
#define PG8_LDB(dst, b, h) do { _Pragma("unroll") for (int n = 0; n < 2; ++n) _Pragma("unroll") for (int k = 0; k < 2; ++k) dst[n][k] = *(const LAS bf16x8*)(lds + PG8_SB(b, h) + boff + n * 2048 + k * 1024); } while (0)
#define PG8_MMA(ai, bj, At, Bt) do { __builtin_amdgcn_s_setprio(1); _Pragma("unroll") for (int m = 0; m < 4; ++m) _Pragma("unroll") for (int n = 0; n < 2; ++n) _Pragma("unroll") for (int k = 0; k < 2; ++k) \
        acc[ai][bj][m][n] = __builtin_amdgcn_mfma_f32_16x16x32_bf16(Bt[n][k], At[m][k], acc[ai][bj][m][n], 0, 0, 0); __builtin_amdgcn_s_setprio(0); } while (0)
#define PG8_WAIT_V(n) asm volatile("s_waitcnt vmcnt(" #n ")" ::: "memory")
#define PG8_WAIT_L(n) asm volatile("s_waitcnt lgkmcnt(" #n ")" ::: "memory")
#define PG8_BAR __builtin_amdgcn_s_barrier()
#define PG8_SCHED __builtin_amdgcn_sched_barrier(0)
#define PG8_BPTR(u) ((const char*)g.Bt + ((size_t)((u).pm / g.tpg) * g.bgs) * 2 + (size_t)(u).pn * tB)
#define PG8_AOFF(dstv, u) do { _Pragma("unroll") for (int _h = 0; _h < 2; ++_h) _Pragma("unroll") for (int _i = 0; _i < 2; ++_i) { \
        if (GATHER) dstv[_h][_i] = (unsigned)g.gidx[(u).pm * BM + _h * HALF + rA[_i]] * (unsigned)(g.lda * 2) + (unsigned)cA2[_i]; \
        else dstv[_h][_i] = (unsigned)(rA[_i] * g.lda * 2 + cA2[_i]); } } while (0)
#define PG8_ABASE(u) (GATHER ? (const char*)g.A : (const char*)g.A + (size_t)(u).pm * tA)
    Unit cur, nxt; int ui = 0;
    if (!S.next(0, cur)) return;
    f32x4 acc[2][2][4][2];
#pragma unroll
    for (int a = 0; a < 2; ++a)
#pragma unroll
        for (int b = 0; b < 2; ++b)
#pragma unroll
            for (int m = 0; m < 4; ++m)
#pragma unroll
                for (int n = 0; n < 2; ++n) acc[a][b][m][n] = (f32x4){0.f, 0.f, 0.f, 0.f};
    bf16x8 At[4][2], B0[2][2], B1[2][2];
    unsigned vA[2][2], vN[2][2];
    PG8_AOFF(vA, cur);
    const char* cA = PG8_ABASE(cur); const char* cB = PG8_BPTR(cur);
    PG8_STAGE(PG8_SB(0, 0), cB, voffB); PG8_STAGE(PG8_SA(0, 0), cA, vA[0]); PG8_STAGE(PG8_SB(0, 1), cB + hB, voffB); PG8_STAGE(PG8_SA(0, 1), GATHER ? cA : cA + hA, GATHER ? vA[1] : vA[0]);
    if (wr == 1) PG8_BAR;
    PG8_WAIT_V(4); PG8_BAR;
    PG8_STAGE(PG8_SB(1, 0), cB + kstep, voffB); PG8_STAGE(PG8_SA(1, 0), cA + kstep, vA[0]); PG8_STAGE(PG8_SB(1, 1), cB + hB + kstep, voffB);
    PG8_WAIT_V(6); PG8_BAR;
    for (;;) {
        const bool has_next = S.next(ui + 1, nxt);
        const char* nA = has_next ? PG8_ABASE(nxt) : cA; const char* nB = has_next ? PG8_BPTR(nxt) : cB;
        if (GATHER) {
            if (has_next) { PG8_AOFF(vN, nxt); }
            else {
#pragma unroll
                for (int _h = 0; _h < 2; ++_h)
#pragma unroll
                    for (int _i = 0; _i < 2; ++_i) vN[_h][_i] = vA[_h][_i]; }
        }
        const bool skip1 = g.halftile >= 0 && (cur.pm % g.tpg) == g.halftile;
#pragma unroll 1
        for (int t = 0; t < nt; t += 2) {
            const bool last = (t == nt - 2);
            const char* a1 = cA + (size_t)(t + 1) * kstep;
            const char* a2 = last ? nA : cA + (size_t)(t + 2) * kstep; const char* b2 = last ? nB : cB + (size_t)(t + 2) * kstep;
            const char* a3 = a2 + kstep; const char* b3 = b2 + kstep;
            unsigned v2[2][2];
#pragma unroll
            for (int _h = 0; _h < 2; ++_h)
#pragma unroll
                for (int _i = 0; _i < 2; ++_i) v2[_h][_i] = (GATHER && last) ? vN[_h][_i] : vA[_h][_i];
            PG8_LDB(B0, 0, 0); PG8_SCHED; PG8_LDA(At, 0, 0); PG8_STAGE(PG8_SA(1, 1), GATHER ? a1 : a1 + hA, GATHER ? vA[1] : vA[0]);
            PG8_WAIT_L(8); PG8_BAR; PG8_WAIT_L(0); PG8_MMA(0, 0, At, B0); PG8_BAR; PG8_SCHED;
            PG8_LDB(B1, 0, 1); PG8_STAGE(PG8_SB(0, 0), b2, voffB);
            PG8_BAR; PG8_WAIT_L(0); PG8_MMA(0, 1, At, B1); PG8_BAR;
            PG8_LDA(At, 0, 1); PG8_STAGE(PG8_SA(0, 0), a2, v2[0]);
            PG8_BAR; PG8_WAIT_L(0); if (!skip1) PG8_MMA(1, 0, At, B0); PG8_BAR; PG8_SCHED;
            PG8_STAGE(PG8_SB(0, 1), b2 + hB, voffB);
            PG8_WAIT_V(6); PG8_BAR; if (!skip1) PG8_MMA(1, 1, At, B1); PG8_BAR;
            PG8_LDB(B0, 1, 0); PG8_SCHED; PG8_LDA(At, 1, 0); PG8_STAGE(PG8_SA(0, 1), GATHER ? a2 : a2 + hA, GATHER ? v2[1] : v2[0]);
            PG8_WAIT_L(8); PG8_BAR; PG8_WAIT_L(0); PG8_MMA(0, 0, At, B0); PG8_BAR; PG8_SCHED;
            PG8_LDB(B1, 1, 1); PG8_STAGE(PG8_SB(1, 0), b3, voffB);
            PG8_BAR; PG8_WAIT_L(0); PG8_MMA(0, 1, At, B1); PG8_BAR;
            PG8_LDA(At, 1, 1); PG8_STAGE(PG8_SA(1, 0), a3, v2[0]);
            PG8_BAR; PG8_WAIT_L(0); if (!skip1) PG8_MMA(1, 0, At, B0); PG8_BAR; PG8_SCHED;
            PG8_STAGE(PG8_SB(1, 1), b3 + hB, voffB);
            PG8_WAIT_V(6); PG8_BAR; if (!skip1) PG8_MMA(1, 1, At, B1); PG8_BAR;
        }
        { int fr_ = fr, fq_ = fq; asm volatile("" : "+v"(fr_), "+v"(fq_));
          E(acc, cur, wr, wc, fr_, fq_); }
        if (!has_next) break;
#pragma unroll
        for (int a = 0; a < 2; ++a)
#pragma unroll
            for (int b = 0; b < 2; ++b)
#pragma unroll
                for (int m = 0; m < 4; ++m)
#pragma unroll
                    for (int n = 0; n < 2; ++n) acc[a][b][m][n] = (f32x4){0.f, 0.f, 0.f, 0.f};
        cur = nxt; cA = nA; cB = nB; ++ui;
        if (GATHER) {
#pragma unroll
            for (int _h = 0; _h < 2; ++_h)
#pragma unroll
                for (int _i = 0; _i < 2; ++_i) vA[_h][_i] = vN[_h][_i]; }
    }
    PG8_WAIT_V(0);
    if (wr == 0) PG8_BAR;
    PG8_BAR;
#undef PG8_SA
#undef PG8_SB
#undef PG8_STAGE
#undef PG8_LDA
#undef PG8_LDB
#undef PG8_MMA
#undef PG8_WAIT_V
#undef PG8_WAIT_L
#undef PG8_BAR
#undef PG8_SCHED
#undef PG8_BPTR
#undef PG8_AOFF
#undef PG8_ABASE
}

template <int MODE> struct EpiBf16 {
    static constexpr bool PERM = true;
    bf16* O; int ldc; const float* bias;
    __device__ __forceinline__ void operator()(const f32x4 (&acc)[2][2][4][2], const Unit& u, int wr, int wc, int fr, int fq) const {
        const int row0 = u.pm * BM + wr * 64 + fr; const int col0 = u.pn * BM + wc * 32 + 8 * fq;
#pragma unroll
        for (int bj = 0; bj < 2; ++bj) {
            f32x4 b0 = (f32x4){0.f, 0.f, 0.f, 0.f}, b1 = b0;
            if (MODE == 2) { b0 = *(const f32x4*)(bias + col0 + bj * HALF); b1 = *(const f32x4*)(bias + col0 + bj * HALF + 4); }
            int act = 0;
            if (MODE == 1) { if (u.pn == 12) act = (bj == 1) ? 2 : (wc < 2 ? 1 : 0); }
            if (MODE == 2) { act = u.pn < 4 ? 3 : (u.pn < 8 ? 2 : 0); }
#pragma unroll
            for (int ai = 0; ai < 2; ++ai)
#pragma unroll
                for (int m = 0; m < 4; ++m) {
                    f32x4 v0 = acc[ai][bj][m][0] + b0, v1 = acc[ai][bj][m][1] + b1;
                    if (MODE != 0) {
                        if (act == 1) {
#pragma unroll
                            for (int j = 0; j < 4; ++j) { v0[j] = tanhf(v0[j]); v1[j] = tanhf(v1[j]); }
                        } else if (act == 2) {
#pragma unroll
                            for (int j = 0; j < 4; ++j) { v0[j] = sigmoidf_(v0[j]); v1[j] = sigmoidf_(v1[j]); }
                        } else if (act == 3) {
#pragma unroll
                            for (int j = 0; j < 4; ++j) { v0[j] = -0.6065306597f * sigmoidf_(v0[j]); v1[j] = -0.6065306597f * sigmoidf_(v1[j]); }
                        }
                    }
                    u32x4 w; w.x = pk2(v0[0], v0[1]); w.y = pk2(v0[2], v0[3]); w.z = pk2(v1[0], v1[1]); w.w = pk2(v1[2], v1[3]);
                    *(u32x4*)(O + (size_t)(row0 + ai * HALF + m * 16) * ldc + col0 + bj * HALF) = w;
                }
        }
    }
};
struct EpiSwiglu {
    static constexpr bool PERM = true;
    bf16* O; int ldc;
    __device__ __forceinline__ void operator()(const f32x4 (&acc)[2][2][4][2], const Unit& u, int wr, int wc, int fr, int fq) const {
        const int row0 = u.pm * BM + wr * 64 + fr; const int col0 = u.pn * HALF + wc * 32 + 8 * fq;
#pragma unroll
        for (int ai = 0; ai < 2; ++ai)
#pragma unroll
            for (int m = 0; m < 4; ++m) {
                f32x4 v0, v1;
#pragma unroll
                for (int j = 0; j < 4; ++j) { const float a0 = acc[ai][0][m][0][j], a1 = acc[ai][0][m][1][j]; v0[j] = a0 * sigmoidf_(a0) * acc[ai][1][m][0][j]; v1[j] = a1 * sigmoidf_(a1) * acc[ai][1][m][1][j]; }
                u32x4 w; w.x = pk2(v0[0], v0[1]); w.y = pk2(v0[2], v0[3]); w.z = pk2(v1[0], v1[1]); w.w = pk2(v1[2], v1[3]);
                *(u32x4*)(O + (size_t)(row0 + ai * HALF + m * 16) * ldc + col0) = w;
            }
    }
};
struct EpiResid {
    static constexpr bool PERM = false;
    const float* xl; const float* xc; float* ol; float* oc; const float* gate;
    __device__ __forceinline__ void operator()(const f32x4 (&acc)[2][2][4][2], const Unit& u, int wr, int wc, int fr, int fq) const {
        const bool isctx = u.pm >= (ML / BM);
        const int rbase = (isctx ? (u.pm - ML / BM) : u.pm) * BM + wr * 64 + fr; const int col0 = u.pn * BM + wc * 32 + 4 * fq;
        const float* xin = isctx ? xc : xl; float* xo = isctx ? oc : ol;
        const int smp = isctx ? 4 : (u.pm >> 5);
        f32x4 gv[2][2];
#pragma unroll
        for (int bj = 0; bj < 2; ++bj)
#pragma unroll
            for (int n = 0; n < 2; ++n) gv[bj][n] = *(const f32x4*)(gate + smp * 6144 + col0 + bj * HALF + n * 16);
#pragma unroll
        for (int ai = 0; ai < 2; ++ai)
#pragma unroll
            for (int m = 0; m < 4; ++m) { const size_t off = (size_t)(rbase + ai * HALF + m * 16) * D + col0;
#pragma unroll
                for (int bj = 0; bj < 2; ++bj)
#pragma unroll
                    for (int n = 0; n < 2; ++n) { const f32x4 xv = *(const f32x4*)(xin + off + bj * HALF + n * 16); *(f32x4*)(xo + off + bj * HALF + n * 16) = xv + gv[bj][n] * acc[ai][bj][m][n]; }
                asm volatile("" ::: "memory"); }
    }
};
}

#define XB_TMO      128
#define XB_XCNT(j)  (256  + 64 * (j))
#define XB_XSUB(j)  (1280 + 64 * (j))
#define XB_XGEN(j)  (2304 + 64 * (j))
#define XB_TOP      3328
#define XB_TOPGEN   3392
#define XCD_BAR_WORDS 3456
#define XB_SPIN_CAP (1u << 20)
__device__ __forceinline__ unsigned xb_ld(unsigned* p)              { return __hip_atomic_load(p, __ATOMIC_RELAXED, __HIP_MEMORY_SCOPE_AGENT); }
__device__ __forceinline__ unsigned xb_add(unsigned* p, unsigned v) { return __hip_atomic_fetch_add(p, v, __ATOMIC_RELAXED, __HIP_MEMORY_SCOPE_AGENT); }
__device__ __forceinline__ unsigned xb_xcc_id() { return (unsigned)__builtin_amdgcn_s_getreg((3 << 11) | 20) & 0xFu; }
#define XB_SPIN(cond, bar) do { unsigned _sp = 0; while (cond) { __builtin_amdgcn_s_sleep(1); \
    if ((++_sp & 255u) == 0u) { if (xb_ld(&(bar)[XB_TMO])) break; if (_sp > XB_SPIN_CAP) { atomicAdd(&(bar)[XB_TMO], 1u); break; } } } } while (0)
struct XcdBarrier { unsigned* bar; unsigned x; volatile LAS unsigned* st; };
__device__ __forceinline__ XcdBarrier xcd_barrier_post(unsigned* bar, volatile LAS unsigned* st) {
    XcdBarrier b; b.bar = bar; b.x = xb_xcc_id(); b.st = st;
    if (threadIdx.x == 0) (void)xb_add(&bar[XB_XCNT(b.x)], 1u);
    return b;
}
__device__ __forceinline__ void xcd_barrier_complete(unsigned* bar, unsigned x, unsigned& nloc, unsigned& nx) {
    const unsigned G = gridDim.x * gridDim.y * gridDim.z;
    unsigned sum, cnt, mine, sp = 0u;
    for (;;) {
        sum = 0u; cnt = 0u; mine = 0u;
#pragma unroll
        for (unsigned j = 0; j < 16; ++j) { const unsigned c = xb_ld(&bar[XB_XCNT(j)]); sum += c; cnt += (c > 0u) ? 1u : 0u; mine = (j == x) ? c : mine; }
        if (sum == G) break;
        __builtin_amdgcn_s_sleep(1);
        if ((++sp & 255u) == 0u) { if (xb_ld(&bar[XB_TMO])) break; if (sp > XB_SPIN_CAP) { atomicAdd(&bar[XB_TMO], 1u); break; } }
    }
    nloc = mine > 0u ? mine : 1u; nx = cnt > 0u ? cnt : 1u;
}
__device__ __forceinline__ void xcd_barrier(const XcdBarrier& b) {
    asm volatile("s_waitcnt vmcnt(0)" ::: "memory");
    __syncthreads();
    if (threadIdx.x == 0) {
        unsigned* bar = b.bar;
        __builtin_amdgcn_s_waitcnt(0);
        unsigned nloc = b.st[0], nx = b.st[1];
        if (nloc == 0u) { xcd_barrier_complete(bar, b.x, nloc, nx); b.st[0] = nloc; b.st[1] = nx; }
        const unsigned old = xb_add(&bar[XB_XSUB(b.x)], 1u);
        const unsigned gen = old / nloc;
        if (old + 1u == (gen + 1u) * nloc) {
            __builtin_amdgcn_fence(__ATOMIC_RELEASE, "agent");
            asm volatile("s_waitcnt vmcnt(0)" ::: "memory");
            const unsigned og = xb_add(&bar[XB_TOP], 1u);
            const unsigned tg = og / nx;
            if (og + 1u == (tg + 1u) * nx) xb_add(&bar[XB_TOPGEN], 1u);
            else XB_SPIN(xb_ld(&bar[XB_TOPGEN]) == tg, bar);
            __builtin_amdgcn_fence(__ATOMIC_ACQUIRE, "agent");
            xb_add(&bar[XB_XGEN(b.x)], 1u);
            asm volatile("s_waitcnt vmcnt(0)" ::: "memory");
        } else {
            XB_SPIN(xb_ld(&bar[XB_XGEN(b.x)]) == gen, bar);
            __builtin_amdgcn_fence(__ATOMIC_ACQUIRE, "agent");
            asm volatile("s_waitcnt vmcnt(0)" ::: "memory");
        }
    }
    __syncthreads();
}

struct Args { const float* in[33]; float* out; unsigned char* ws; int ph_lo, ph_hi; };
typedef const Args __attribute__((address_space(4))) CArgs;
enum { I_X = 0, I_C, I_CTX, I_CCTX, I_ADAW, I_ADAB, I_N1G, I_N2G, I_EVWIN, I_EVWOUT, I_CONVW, I_KK, I_KA, I_RK, I_W0, I_WUP, I_A0, I_AUP, I_GUP, I_LNG, I_LNB,
       I_ODWIN, I_ODWOUT, I_QNG, I_KNG, I_RPB, I_GAUP, I_GAB, I_GLNG, I_ROUTER, I_W1, I_W3, I_W2 };

template <int NLD = 64>
__device__ __forceinline__ void transpose_item(const float* W, int K, int N, bf16* WT, int ldt, int item, int maptype, LAS unsigned char* tile, int lane) {
    const int nblk = (N + 63) / 64, kb = item / nblk, nb = item % nblk, k0 = 64 * kb, n0 = 64 * nb;
    const int drow0 = maptype == 0 ? n0 : ((n0 >> 7) * 256 + (n0 & 127) + (maptype == 2 ? 128 : 0));
    const bool nok = (n0 + lane) < N;
    const float* src = W + (size_t)k0 * N + n0 + (nok ? lane : 0);
#pragma unroll
    for (int hh = 0; hh < 64 / NLD; ++hh) {
        float f[NLD];
#pragma unroll
        for (int e = 0; e < NLD; ++e) f[e] = __builtin_nontemporal_load(src + (size_t)(hh * NLD + e) * N);
#pragma unroll
        for (int g = 0; g < NLD / 8; ++g) { const int gg = hh * (NLD / 8) + g;
            u32x4 o0;
            o0.x = pk2(f[8 * g + 0], f[8 * g + 1]); o0.y = pk2(f[8 * g + 2], f[8 * g + 3]); o0.z = pk2(f[8 * g + 4], f[8 * g + 5]); o0.w = pk2(f[8 * g + 6], f[8 * g + 7]);
            if (!nok) o0 = (u32x4){0u, 0u, 0u, 0u};
            *(LAS u32x4*)(tile + lane * 128 + ((gg ^ (lane & 7)) << 4)) = o0; }
    }
    asm volatile("s_waitcnt lgkmcnt(0)" ::: "memory");
    const int ch = lane & 7;
#pragma unroll
    for (int it = 0; it < 8; ++it) { const int r = (lane >> 3) + 8 * it;
        const u32x4 v = *(const LAS u32x4*)(tile + r * 128 + ((ch ^ (r & 7)) << 4));
        *(u32x4*)(WT + (size_t)(drow0 + r) * ldt + k0 + 8 * ch) = v; }
    asm volatile("s_waitcnt lgkmcnt(0)" ::: "memory");
}
template <int NLD = 64>
__device__ __forceinline__ void moe_convert_item(CArgs& a, int l, int it, LAS unsigned char* tile, int lane) {
    bf16* W13T = (bf16*)(a.ws + WS_W13T); bf16* W2T = (bf16*)(a.ws + WS_W2T);
    const int e = it / 1152, r = it % 1152, which = r / 384, sub = r % 384;
    const size_t wo = ((size_t)l * NE + e) * (size_t)D * DE;
    if (which == 0) transpose_item<NLD>(a.in[I_W1] + wo, D, DE, W13T + (size_t)e * 3072 * D, D, sub, 1, tile, lane);
    else if (which == 1) transpose_item<NLD>(a.in[I_W3] + wo, D, DE, W13T + (size_t)e * 3072 * D, D, sub, 2, tile, lane);
    else transpose_item<NLD>(a.in[I_W2] + wo, DE, D, W2T + (size_t)e * D * DE, DE, sub, 0, tile, lane);
}
__device__ __forceinline__ void moe_convert(CArgs& a, int l, LAS unsigned char* tile, int gw, int NGW, int lane) {
    for (int it = gw; it < 16 * 1152; it += NGW) moe_convert_item(a, l, it, tile, lane);
}

__device__ __forceinline__ void ph_prologue(CArgs& a, LAS unsigned char* lds, int tid, int wave, int lane) {
    const int G = gridDim.x, bid = blockIdx.x;
    float* mod = (float*)(a.ws + WS_MOD);
    LAS float* fl = (LAS float*)lds;
    for (int item = bid; item < 192; item += G) {
        const int l = item / 96, nb = item % 96;
        for (int i = tid; i < 5 * 1024; i += NTHREADS) { const int s = i >> 10, k = i & 1023; const float v = s < 4 ? a.in[I_C][s * 1024 + k] : a.in[I_CCTX][k]; fl[i] = v * __builtin_amdgcn_rcpf(1.0f + __expf(-v)); }
        __syncthreads();
        const int n = nb * 64 + (tid & 63), kg = tid >> 6;
        const float* W = a.in[I_ADAW] + (size_t)l * D * 6144 + n;
        float s0 = 0.f, s1 = 0.f, s2 = 0.f, s3 = 0.f, s4 = 0.f;
#pragma unroll 8
        for (int k = kg * 128; k < kg * 128 + 128; ++k) { const float w = W[(size_t)k * 6144]; s0 += fl[k] * w; s1 += fl[1024 + k] * w; s2 += fl[2048 + k] * w; s3 += fl[3072 + k] * w; s4 += fl[4096 + k] * w; }
        LAS float* red = fl + 5120;
        red[(kg * 5 + 0) * 64 + (tid & 63)] = s0; red[(kg * 5 + 1) * 64 + (tid & 63)] = s1; red[(kg * 5 + 2) * 64 + (tid & 63)] = s2; red[(kg * 5 + 3) * 64 + (tid & 63)] = s3; red[(kg * 5 + 4) * 64 + (tid & 63)] = s4;
        __syncthreads();
        if (tid < 320) { const int s = tid >> 6, nn = tid & 63; float t = 0.f;
#pragma unroll
            for (int q = 0; q < 8; ++q) t += red[(q * 5 + s) * 64 + nn];
            mod[(l * 5 + s) * 6144 + nb * 64 + nn] = t + a.in[I_ADAB][l * 6144 + nb * 64 + nn]; }
        __syncthreads();
    }
    {
        bf16* WB2T = (bf16*)(a.ws + WS_WB2T); float* bias2 = (float*)(a.ws + WS_BIAS2); float* rope = (float*)(a.ws + WS_ROPE); bf16* WIN1 = (bf16*)(a.ws + WS_WIN1);
        const int gt = bid * NTHREADS + tid, GT = G * NTHREADS;
        for (int i = gt; i < NQ2 * 256; i += GT) {
            const int n = i >> 8, k = i & 255; float v = 0.f;
            if (n < 1024) { if (k < 64) v = a.in[I_WUP][((n >> 9) * 64 + k) * 512 + (n & 511)]; }
            else if (n < 2048) { if (k >= 64 && k < 128) v = a.in[I_AUP][(((n - 1024) >> 9) * 64 + (k - 64)) * 512 + (n & 511)]; }
            else { if (k >= 128) v = a.in[I_GUP][(k - 128) * 512 + (n - 2048)]; }
            WB2T[i] = (bf16)f2bf(v);
        }
        for (int i = gt; i < NQ2; i += GT) bias2[i] = i < 1024 ? a.in[I_W0][i] : (i < 2048 ? a.in[I_A0][i - 1024] : 0.f);
        for (int i = gt; i < 128 * 16; i += GT) { const int pos = i >> 4, f = i & 15; const float inv = powf(10000.0f, -(float)f / 16.0f); const float ang = (float)pos * inv; float sn, cs; sincosf(ang, &sn, &cs); rope[2 * i] = cs; rope[2 * i + 1] = sn; }
        for (int i = gt; i < (NIN - 3136) * D / 8; i += GT) *(u32x4*)(WIN1 + (size_t)3136 * D + (size_t)i * 8) = (u32x4){0u, 0u, 0u, 0u};
    }
    {
        const int gw = bid * NWAVES + wave, NGW = G * NWAVES;
        __syncthreads();
        for (int it = gw; it < 2128; it += NGW) {
            int r = it;
            if (r < 832) { transpose_item(a.in[I_EVWIN], D, NIN, (bf16*)(a.ws + WS_WIN0), D, r, 0, lds + wave * 8192, lane); continue; } r -= 832;
            if (r < 256) { transpose_item(a.in[I_EVWOUT], D, D, (bf16*)(a.ws + WS_WOUT0), D, r, 0, lds + wave * 8192, lane); continue; } r -= 256;
            if (r < 784) { transpose_item(a.in[I_ODWIN], D, ODD_IN, (bf16*)(a.ws + WS_WIN1), D, r, 0, lds + wave * 8192, lane); continue; } r -= 784;
            transpose_item(a.in[I_ODWOUT], D, D, (bf16*)(a.ws + WS_WOUT1), D, r, 0, lds + wave * 8192, lane);
        }
    }
}

__device__ __forceinline__ void norm_mod_store(const f32x4 (&v)[4], float rstd, const float* g, const float* sc, const float* sh, bf16* orow, int lane, f32x4 (&hout)[4]) {
    unsigned long long* o8 = (unsigned long long*)orow + lane;
#pragma unroll
    for (int j = 0; j < 4; ++j) {
        const f32x4 gg = *((const f32x4*)g + lane + 64 * j), s1 = *((const f32x4*)sc + lane + 64 * j), s0 = *((const f32x4*)sh + lane + 64 * j);
        f32x4 h = v[j] * rstd * gg * (s1 + 1.0f) + s0; hout[j] = h;
        o8[64 * j] = (unsigned long long)pk2(h.x, h.y) | ((unsigned long long)pk2(h.z, h.w) << 32);
    }
}
__device__ __forceinline__ float row_rstd(const f32x4 (&v)[4]) {
    float s = 0.f;
#pragma unroll
    for (int j = 0; j < 4; ++j) s += (v[j].x * v[j].x + v[j].y * v[j].y) + (v[j].z * v[j].z + v[j].w * v[j].w);
    return rsqrtf(wave_sum(s) * (1.0f / D) + 1e-6f);
}
__device__ __forceinline__ void ph_norm1_l0(CArgs& a, int wave, int lane) {
    const int gw = blockIdx.x * NWAVES + wave, NGW = gridDim.x * NWAVES;
    const float* mod = (const float*)(a.ws + WS_MOD); bf16* ACT = (bf16*)(a.ws + WS_ACT);
    for (int grp = gw; grp < MT / 4; grp += NGW) {
        f32x4 v[4][4];
#pragma unroll
        for (int rr = 0; rr < 4; ++rr) { const int m = 4 * grp + rr; const float* xr = m < ML ? a.in[I_X] + (size_t)m * D : a.in[I_CTX] + (size_t)(m - ML) * D;
#pragma unroll
            for (int j = 0; j < 4; ++j) v[rr][j] = *((const f32x4*)xr + lane + 64 * j); }
#pragma unroll
        for (int rr = 0; rr < 4; ++rr) { const int m = 4 * grp + rr; f32x4 h[4];
            const float rstd = row_rstd(v[rr]); const float* ms = mod + (size_t)(0 * 5 + sample_of(m)) * 6144;
            norm_mod_store(v[rr], rstd, a.in[I_N1G], ms + 1024, ms, ACT + (size_t)m * D, lane, h); }
    }
}

__device__ __forceinline__ int scan_row(int tau, int b, int d) {
    const bool isctx = tau < CTXL; int t = isctx ? tau : tau - CTXL;
    if (d) t = (isctx ? (CTXL - 1) : (SEQ - 1)) - t;
    return isctx ? (ML + b * CTXL + t) : (b * SEQ + t);
}
constexpr int RW_PT = 72, RW_IMG = 64 * RW_PT * 2;
constexpr int RW_NCH = (CTXL + SEQ) / 64;
constexpr int RW_CONV_SEQ = 6144;
__device__ __forceinline__ bf16* rw_ops(unsigned char* ws, int it) { return (bf16*)(it < 5632 ? ws + WS_Q2 + 33 * MiB + (size_t)it * 24576 : ws + WS_ACT + (size_t)(it - 5632) * 24576); }
__device__ __forceinline__ f32x4 mfma16(bf16x8 a, bf16x8 b, f32x4 c) { return __builtin_amdgcn_mfma_f32_16x16x32_bf16(a, b, c, 0, 0, 0); }
#define RW_FRAG(img, row, k0) (*(const LAS bf16x8*)((img) + (row) * RW_PT + (k0)))
__device__ __forceinline__ void ph_rwkv_prep(CArgs& a, LAS unsigned char* lds, int tid, int wave, int lane) {
    const bf16* P = (const bf16*)(a.ws + WS_P); const bf16* Q2 = (const bf16*)(a.ws + WS_Q2);
    LAS bf16* At = (LAS bf16*)(lds + 0 * RW_IMG); LAS bf16* Bt = (LAS bf16*)(lds + 1 * RW_IMG); LAS bf16* Kt = (LAS bf16*)(lds + 2 * RW_IMG); LAS bf16* Rt = (LAS bf16*)(lds + 3 * RW_IMG);
    LAS bf16* BTr = (LAS bf16*)(lds + 4 * RW_IMG); LAS bf16* VTr = (LAS bf16*)(lds + 5 * RW_IMG); LAS bf16* LbaT = (LAS bf16*)(lds + 6 * RW_IMG); LAS bf16* LkaT = (LAS bf16*)(lds + 7 * RW_IMG);
    LAS bf16* MbrT = (LAS bf16*)(lds + 8 * RW_IMG); LAS bf16* MkrT = (LAS bf16*)(lds + 9 * RW_IMG); LAS bf16* X1 = (LAS bf16*)(lds + 10 * RW_IMG);
    LAS bf16* X0 = Bt; LAS bf16* G2T = LbaT; LAS bf16* H2T = LkaT;
    LAS bf16* Wm = (LAS bf16*)(lds + 11 * RW_IMG) + wave * 16 * 32;
    LAS bf16* DT = (LAS bf16*)(lds + 11 * RW_IMG + 8192);
    LAS float* Lf = (LAS float*)(lds + 11 * RW_IMG + 8192 + 4096);
    LAS bf16* G1img = At; LAS bf16* H1img = (LAS bf16*)(lds + 11 * RW_IMG + 18944); LAS bf16* Yimg = Kt; LAS bf16* Svimg = Rt;
    LAS float* PC = Lf + 1024;
    LAS float* SEG = PC + 64;
    LAS float* NRM = SEG + 512;
    LAS bf16* RAWr = LbaT; LAS bf16* RAWk = LkaT; LAS bf16* RAWv = MbrT; LAS bf16* RAWw = MkrT; LAS bf16* RAWa = X1;
    const int lr = lane & 15, lq = lane >> 4;
    __syncthreads();
    for (int i = tid; i < RW_IMG / 4; i += NTHREADS) ((LAS unsigned*)X1)[i] = 0u;
    for (int i = tid; i < (8192 + 4096) / 4; i += NTHREADS) ((LAS unsigned*)(lds + 11 * RW_IMG))[i] = 0u;
    u32x4 g_r, g_k, g_v, g_w, g_a;
#define RWP_LOAD(it_) do { const int seq_ = (it_) / RW_NCH, n_ = (it_) % RW_NCH, b_ = seq_ >> 4, h_ = (seq_ >> 1) & 7, d_ = seq_ & 1; \
        const int m_ = scan_row(64 * n_ + (tid >> 3), b_, d_); const bf16* pr_ = P + (size_t)m_ * NIN + h_ * 64 + 8 * (tid & 7); g_r = *(const u32x4*)(pr_ + 1536); g_k = *(const u32x4*)(pr_ + 2048); g_v = *(const u32x4*)(pr_ + 2560); \
        const int mq_ = scan_row(64 * n_ + 16 * (wave & 3) + lr, b_, d_); const bf16* qr_ = P + (size_t)mq_ * NIN + 3072 + (wave >> 2) * 64 + 8 * lq;     \
        g_w = *(const u32x4*)(qr_); g_a = *(const u32x4*)(qr_ + 32); } while (0)
    if ((int)blockIdx.x < 64 * RW_NCH) RWP_LOAD((int)blockIdx.x);
    int kiter = 0;
    for (int it = blockIdx.x; it < 64 * RW_NCH; it += gridDim.x) {
        const int seq = it / RW_NCH, n = it % RW_NCH, b = seq >> 4, h = (seq >> 1) & 7, d = seq & 1;
        bf16* Y = (bf16*)(a.ws + (d ? WS_Y1 : WS_Y0)); bf16* ops = rw_ops(a.ws, it);
        bf16x8 bw[4][2];
        { const bf16* WB_ = (const bf16*)(a.ws + WS_WB2T) + (size_t)((wave >> 2) * 1024 + d * 512 + h * 64 + lr) * 256 + (wave >> 2) * 64 + 8 * lq;
#pragma unroll
          for (int nj = 0; nj < 4; ++nj) { bw[nj][0] = *(const bf16x8*)(WB_ + (size_t)16 * nj * 256); bw[nj][1] = *(const bf16x8*)(WB_ + (size_t)16 * nj * 256 + 32); } }
        LDS_BARRIER();
        {
            const int i = tid >> 3, c8 = 8 * (tid & 7);
            *(LAS u32x4*)(RAWr + i * RW_PT + c8) = g_r; *(LAS u32x4*)(RAWk + i * RW_PT + c8) = g_k; *(LAS u32x4*)(RAWv + i * RW_PT + c8) = g_v;
            float kf[8], kk8[8]; unpack8(g_k, kf); load8f(a.in[I_KK] + h * 64 + c8, kk8); float ss = 0.f;
#pragma unroll
            for (int e = 0; e < 8; ++e) { const float x = kf[e] * kk8[e]; ss += x * x; }
            ss += __shfl_xor(ss, 1); ss += __shfl_xor(ss, 2); ss += __shfl_xor(ss, 4);
            if ((tid & 7) == 0) NRM[i] = rsqrtf(ss + 1e-12f);
        }
        {
            const int p_ = wave >> 2, mi = wave & 3; LAS bf16* Oi = p_ ? Bt : At;
            const float* bias = (const float*)(a.ws + WS_BIAS2) + p_ * 1024 + d * 512 + h * 64;
            const bf16x8 af0 = __builtin_bit_cast(bf16x8, g_w), af1 = __builtin_bit_cast(bf16x8, g_a);
#pragma unroll
            for (int nj = 0; nj < 4; ++nj) { f32x4 acc = (f32x4){0.f, 0.f, 0.f, 0.f};
                acc = mfma16(af0, bw[nj][0], acc); acc = mfma16(af1, bw[nj][1], acc);
                const float bs = bias[16 * nj + lr];
#pragma unroll
                for (int rg = 0; rg < 4; ++rg) { const float sg = sigmoidf_(acc[rg] + bs); Oi[(16 * mi + 4 * lq + rg) * RW_PT + 16 * nj + lr] = (bf16)f2bf(p_ ? sg : -0.6065306597f * sg); } }
        }
        if (it + (int)gridDim.x < 64 * RW_NCH) RWP_LOAD(it + (int)gridDim.x);
        LDS_BARRIER();
        {
            const int j = lane; const float k_k = a.in[I_KK][h * 64 + j], k_a = a.in[I_KA][h * 64 + j];
            float r_[8], k_[8], v_[8], lw_[8], a_[8];
#pragma unroll
            for (int e = 0; e < 8; ++e) { const int o = (8 * wave + e) * RW_PT + j; r_[e] = bf2f(RAWr[o]); k_[e] = bf2f(RAWk[o]); v_[e] = bf2f(RAWv[o]); lw_[e] = bf2f(At[o]); a_[e] = bf2f(Bt[o]); }
            float c_[8]; float run = 0.f;
#pragma unroll
            for (int e = 0; e < 8; ++e) { run += lw_[e]; c_[e] = run; }
            SEG[wave * 64 + j] = run;
            LDS_BARRIER();
            float off = 0.f, tot = 0.f;
#pragma unroll
            for (int w2 = 0; w2 < 8; ++w2) { const float sg = SEG[w2 * 64 + j]; tot += sg; off += (w2 < wave) ? sg : 0.f; }
            if (wave == 0) PC[j] = __expf(tot);
            float bt_[8];
#pragma unroll
            for (int e = 0; e < 8; ++e) { const int i = 8 * wave + e; const float cum = off + c_[e]; const float Pv = __expf(cum), Pm1 = __expf(cum - lw_[e]), iP = __expf(-cum);
                const float kk = k_[e] * k_k * NRM[i];
                At[i * RW_PT + j] = (bf16)f2bf(-kk * Pm1); bt_[e] = kk * a_[e] * iP; Bt[i * RW_PT + j] = (bf16)f2bf(bt_[e]);
                Kt[i * RW_PT + j] = (bf16)f2bf(k_[e] * (1.0f + (a_[e] - 1.0f) * k_a) * iP); Rt[i * RW_PT + j] = (bf16)f2bf(r_[e] * Pv); }
            *(LAS u32x4*)(BTr + j * RW_PT + 8 * wave) = pack8(bt_);
            *(LAS u32x4*)(VTr + j * RW_PT + 8 * wave) = pack8(v_);
        }
        LDS_BARRIER();
        for (int rep_ = 0; rep_ < REPS(1); ++rep_) {
            const int p = wave >> 1; const LAS bf16* Ai = (p & 1) ? Kt : Bt; const LAS bf16* Bi = (p & 2) ? Rt : At; LAS bf16* Oi = p == 0 ? LbaT : (p == 1 ? LkaT : (p == 2 ? MbrT : MkrT)); const bool strict = p < 2;
#pragma unroll
            for (int tu = 0; tu < 8; ++tu) { const int tl = 8 * (wave & 1) + tu;
                const int mi = tl >> 2, nj = tl & 3; f32x4 acc = (f32x4){0.f, 0.f, 0.f, 0.f};
                if (mi <= nj) {
#pragma unroll
                    for (int ks = 0; ks < 2; ++ks) acc = mfma16(RW_FRAG(Ai, 16 * mi + lr, 32 * ks + 8 * lq), RW_FRAG(Bi, 16 * nj + lr, 32 * ks + 8 * lq), acc);
                    const int t = 16 * nj + lr;
#pragma unroll
                    for (int rg = 0; rg < 4; ++rg) { const int s = 16 * mi + 4 * lq + rg; const bool keep = strict ? (s < t) : (s <= t); acc[rg] = keep ? acc[rg] : 0.f; }
                    if (p == 0 && mi == nj) {
                        *(LAS f32x4*)(Lf + (mi * 16 + lr) * 16 + 4 * lq) = acc;
                        acc = (f32x4){0.f, 0.f, 0.f, 0.f};
                    }
                }
                u32x2 w; w.x = pk2(acc[0], acc[1]); w.y = pk2(acc[2], acc[3]);
                *(LAS u32x2*)(Oi + (16 * nj + lr) * RW_PT + 16 * mi + 4 * lq) = w;
            }
        }
        LDS_BARRIER();
        for (int rep_ = 0; rep_ < REPS(2); ++rep_) if (wave < 4 && lane < 16) {
            const LAS float* L = Lf + wave * 256; float x[16];
#pragma unroll
            for (int t = 0; t < 16; ++t) { float v = (lane == t) ? 1.0f : 0.0f;
#pragma unroll
                for (int u4 = 0; u4 < (t + 3) / 4; ++u4) { const f32x4 lv = *(const LAS f32x4*)(L + t * 16 + 4 * u4);
#pragma unroll
                    for (int e = 0; e < 4; ++e) if (4 * u4 + e < t) v += x[4 * u4 + e] * lv[e]; }
                x[t] = v; DT[(wave * 16 + t) * 32 + lane] = (bf16)f2bf(v); }
        }
        LDS_BARRIER();
        for (int rep_ = 0; rep_ < REPS(3); ++rep_) {
            LAS bf16* Xi = wave < 4 ? X0 : X1; const int rb = 16 * (wave & 3);
            const LAS bf16* Zi = wave < 4 ? At : LkaT;
#pragma unroll
            for (int c = 0; c < 4; ++c) {
                f32x4 acc; { const u32x2 z = *(const LAS u32x2*)(Zi + (16 * c + lr) * RW_PT + rb + 4 * lq); acc[0] = bflo(z.x); acc[1] = bfhi(z.x); acc[2] = bflo(z.y); acc[3] = bfhi(z.y); }
#pragma unroll
                for (int ks = 0; ks < (c + 1) / 2; ++ks) acc = mfma16(RW_FRAG(Xi, rb + lr, 32 * ks + 8 * lq), RW_FRAG(LbaT, 16 * c + lr, 32 * ks + 8 * lq), acc);
#pragma unroll
                for (int rg = 0; rg < 4; ++rg) Wm[(4 * lq + rg) * 32 + lr] = (bf16)f2bf(acc[rg]);
                asm volatile("s_waitcnt lgkmcnt(0)" ::: "memory");
                f32x4 xc = mfma16(*(const LAS bf16x8*)(Wm + lr * 32 + 8 * lq), *(const LAS bf16x8*)(DT + (c * 16 + lr) * 32 + 8 * lq), (f32x4){0.f, 0.f, 0.f, 0.f});
#pragma unroll
                for (int rg = 0; rg < 4; ++rg) Xi[(rb + 4 * lq + rg) * RW_PT + 16 * c + lr] = (bf16)f2bf(xc[rg]);
                asm volatile("s_waitcnt lgkmcnt(0)" ::: "memory");
            }
        }
        LDS_BARRIER();
        for (int rep_ = 0; rep_ < REPS(4); ++rep_) {
            const int q = wave >> 1; const LAS bf16* Ai = (q & 1) ? X1 : X0; const LAS bf16* Bi = (q & 2) ? BTr : MbrT;
#pragma unroll
            for (int tu = 0; tu < 8; ++tu) { const int tl = 8 * (wave & 1) + tu;
                const int mi = tl >> 2, nj = tl & 3; f32x4 acc = (f32x4){0.f, 0.f, 0.f, 0.f};
#pragma unroll
                for (int ks = 0; ks < 2; ++ks) acc = mfma16(RW_FRAG(Ai, 16 * mi + lr, 32 * ks + 8 * lq), RW_FRAG(Bi, 16 * nj + lr, 32 * ks + 8 * lq), acc);
                const int col = 16 * nj + lr, row0 = 16 * mi + 4 * lq;
                if (q == 0) { const u32x2 z = *(const LAS u32x2*)(Rt + col * RW_PT + row0); u32x2 w; w.x = pk2(acc[0] + bflo(z.x), acc[1] + bfhi(z.x)); w.y = pk2(acc[2] + bflo(z.y), acc[3] + bfhi(z.y));
                    *(LAS u32x2*)(G1img + col * RW_PT + row0) = w; }
                else if (q == 1) { const u32x2 z = *(const LAS u32x2*)(MkrT + col * RW_PT + row0); u32x2 w; w.x = pk2(acc[0] + bflo(z.x), acc[1] + bfhi(z.x)); w.y = pk2(acc[2] + bflo(z.y), acc[3] + bfhi(z.y));
                    *(LAS u32x2*)(G2T + col * RW_PT + row0) = w; }
                else if (q == 2) { const float pc = PC[col]; u32x2 w; w.x = pk2((acc[0] + (row0 == col ? 1.f : 0.f)) * pc, (acc[1] + (row0 + 1 == col ? 1.f : 0.f)) * pc); w.y = pk2((acc[2] + (row0 + 2 == col ? 1.f : 0.f)) * pc, (acc[3] + (row0 + 3 == col ? 1.f : 0.f)) * pc);
                    *(LAS u32x2*)(H1img + col * RW_PT + row0) = w; }
                else { const float pc = PC[col]; u32x2 w; w.x = pk2((acc[0] + bf2f(Kt[(row0 + 0) * RW_PT + col])) * pc, (acc[1] + bf2f(Kt[(row0 + 1) * RW_PT + col])) * pc); w.y = pk2((acc[2] + bf2f(Kt[(row0 + 2) * RW_PT + col])) * pc, (acc[3] + bf2f(Kt[(row0 + 3) * RW_PT + col])) * pc);
                    *(LAS u32x2*)(H2T + col * RW_PT + row0) = w; }
            }
        }
        LDS_BARRIER();
        for (int rep_ = 0; rep_ < REPS(5); ++rep_) {
            { const int row = tid >> 3, c8 = 8 * (tid & 7); *((u32x4*)ops + tid) = *(const LAS u32x4*)(G1img + row * RW_PT + c8); *((u32x4*)(ops + 4096) + tid) = *(const LAS u32x4*)(H1img + row * RW_PT + c8); }
            const int q = wave >> 2; const LAS bf16* Ai = q ? H2T : VTr; const LAS bf16* Bi = q ? VTr : G2T; LAS bf16* Oi = q ? Svimg : Yimg;
#pragma unroll
            for (int tu = 0; tu < 4; ++tu) { const int tl = 4 * (wave & 3) + tu;
                const int mi = tl >> 2, nj = tl & 3; f32x4 acc = (f32x4){0.f, 0.f, 0.f, 0.f};
#pragma unroll
                for (int ks = 0; ks < 2; ++ks) acc = mfma16(RW_FRAG(Ai, 16 * mi + lr, 32 * ks + 8 * lq), RW_FRAG(Bi, 16 * nj + lr, 32 * ks + 8 * lq), acc);
                const int col = 16 * nj + lr, row0 = 16 * mi + 4 * lq; u32x2 w; w.x = pk2(acc[0], acc[1]); w.y = pk2(acc[2], acc[3]);
                *(LAS u32x2*)(Oi + col * RW_PT + row0) = w;
            }
        }
        LDS_BARRIER();
        { const int row = tid >> 3, c8 = 8 * (tid & 7); const int m = scan_row(64 * n + row, b, d);
            *(u32x4*)(Y + (size_t)m * 512 + h * 64 + c8) = *(const LAS u32x4*)(Yimg + row * RW_PT + c8); *((u32x4*)(ops + 8192) + tid) = *(const LAS u32x4*)(Svimg + row * RW_PT + c8); }
        const int cbase = (int)gridDim.x > 64 ? RW_CONV_SEQ : 0;
        if (kiter % 5 == 0) { const int cit = cbase + (kiter / 5) * (int)(gridDim.x * NWAVES) + (int)blockIdx.x * NWAVES + wave;
            if (cit < 16 * 1152) moe_convert_item<32>(a, 0, cit, wave < 7 ? lds + (4 + wave) * RW_IMG : lds, lane); }
        ++kiter;
    }
    __syncthreads();
    for (int cit = ((int)gridDim.x > 64 ? RW_CONV_SEQ : 0) + ((kiter + 4) / 5) * (int)(gridDim.x * NWAVES) + (int)blockIdx.x * NWAVES + wave; cit < 16 * 1152; cit += (int)(gridDim.x * NWAVES)) moe_convert_item(a, 0, cit, lds + wave * 8192, lane);
}
__device__ __forceinline__ void ph_rwkv_seq(CArgs& a, LAS unsigned char* lds, int tid, int wave, int lane) {
    const int lr = lane & 15, lq = lane >> 4;
    if ((int)gridDim.x > 64 && (int)blockIdx.x >= 64) {
        const int nw = ((int)gridDim.x - 64) * NWAVES;
        for (int cit = ((int)blockIdx.x - 64) * NWAVES + wave; cit < RW_CONV_SEQ; cit += nw) moe_convert_item(a, 0, cit, lds + wave * 8192, lane);
        return;
    }
    for (int seq = blockIdx.x; seq < 64; seq += gridDim.x) {
        const int b = seq >> 4, h = (seq >> 1) & 7, d = seq & 1;
        bf16* Y = (bf16*)(a.ws + (d ? WS_Y1 : WS_Y0));
        __syncthreads();
        for (int i = tid; i < RW_IMG / 2; i += NTHREADS) ((LAS unsigned*)lds)[i] = 0u;
        __syncthreads();
        bf16x8 fr[2]; u32x2 ad[4]; bf16* yp = Y;
        const int w4 = wave & 3;
#define RW_SEQ_LOAD(n_) do { const bf16* ops_ = rw_ops(a.ws, seq * RW_NCH + (n_)); \
            if (wave < 4) { _Pragma("unroll") for (int ks = 0; ks < 2; ++ks) fr[ks] = *(const bf16x8*)(ops_ + (16 * wave + lr) * 64 + 32 * ks + 8 * lq); \
                const int m_ = scan_row(64 * (n_) + 16 * wave + lr, b, d); yp = Y + (size_t)m_ * 512 + h * 64 + 4 * lq; \
                _Pragma("unroll") for (int mi = 0; mi < 4; ++mi) ad[mi] = *(const u32x2*)(yp + 16 * mi); } \
            else { _Pragma("unroll") for (int ks = 0; ks < 2; ++ks) fr[ks] = *(const bf16x8*)(ops_ + 4096 + (16 * w4 + lr) * 64 + 32 * ks + 8 * lq); \
                _Pragma("unroll") for (int ni = 0; ni < 4; ++ni) ad[ni] = *(const u32x2*)(ops_ + 8192 + (16 * ni + lr) * 64 + 16 * w4 + 4 * lq); } } while (0)
        RW_SEQ_LOAD(0);
        for (int n = 0; n < RW_NCH; ++n) {
            const LAS bf16* Sc = (const LAS bf16*)(lds + (n & 1) * RW_IMG); LAS bf16* Sn = (LAS bf16*)(lds + ((n & 1) ^ 1) * RW_IMG);
            bf16x8 cf[2]; u32x2 ca[4]; bf16* cyp = yp;
#pragma unroll
            for (int ks = 0; ks < 2; ++ks) cf[ks] = fr[ks];
#pragma unroll
            for (int q = 0; q < 4; ++q) ca[q] = ad[q];
            if (n + 1 < RW_NCH) RW_SEQ_LOAD(n + 1);
            if (wave < 4) {
#pragma unroll
                for (int mi = 0; mi < 4; ++mi) { f32x4 acc = (f32x4){bflo(ca[mi].x), bfhi(ca[mi].x), bflo(ca[mi].y), bfhi(ca[mi].y)};
#pragma unroll
                    for (int ks = 0; ks < 2; ++ks) acc = mfma16(RW_FRAG(Sc, 16 * mi + lr, 32 * ks + 8 * lq), cf[ks], acc);
                    u32x2 w; w.x = pk2(acc[0], acc[1]); w.y = pk2(acc[2], acc[3]); *(u32x2*)(cyp + 16 * mi) = w; }
            } else {
#pragma unroll
                for (int ni = 0; ni < 4; ++ni) { f32x4 acc = (f32x4){bflo(ca[ni].x), bfhi(ca[ni].x), bflo(ca[ni].y), bfhi(ca[ni].y)};
#pragma unroll
                    for (int ks = 0; ks < 2; ++ks) acc = mfma16(cf[ks], RW_FRAG(Sc, 16 * ni + lr, 32 * ks + 8 * lq), acc);
                    u32x2 w; w.x = pk2(acc[0], acc[1]); w.y = pk2(acc[2], acc[3]); *(LAS u32x2*)(Sn + (16 * ni + lr) * RW_PT + 16 * w4 + 4 * lq) = w; }
            }
            LDS_BARRIER();
        }
#undef RW_SEQ_LOAD
    }
}

__device__ __forceinline__ void ph_rwkv_readout(CArgs& a, int wave, int lane) {
    const int gw = blockIdx.x * NWAVES + wave, NGW = gridDim.x * NWAVES;
    const bf16* P = (const bf16*)(a.ws + WS_P); const bf16* Q2 = (const bf16*)(a.ws + WS_Q2);
    const bf16* Y0 = (const bf16*)(a.ws + WS_Y0); const bf16* Y1 = (const bf16*)(a.ws + WS_Y1); bf16* ACT = (bf16*)(a.ws + WS_ACT);
    const int c8 = 8 * lane;
    float cw0[8], cw1[8], cw2[8], lng[8], lnb[8], rk[8];
    load8f(a.in[I_CONVW] + c8, cw0); load8f(a.in[I_CONVW] + 512 + c8, cw1); load8f(a.in[I_CONVW] + 1024 + c8, cw2);
    load8f(a.in[I_LNG] + c8, lng); load8f(a.in[I_LNB] + c8, lnb); load8f(a.in[I_RK] + c8, rk);
    for (int m = gw; m < MT; m += NGW) {
        int t, L; if (m < ML) { t = m & (SEQ - 1); L = SEQ; } else { t = (m - ML) & (CTXL - 1); L = CTXL; }
        const bf16* pr = P + (size_t)m * NIN;
        const u32x4 z4 = (u32x4){0u, 0u, 0u, 0u};
        float u[8], gb[8], gc[8], up[8], gcp[8], un[8], gcn[8], o[8];
        unpack8(*(const u32x4*)(pr + c8), u); unpack8(*(const u32x4*)(pr + 512 + c8), gb); unpack8(*(const u32x4*)(pr + 1024 + c8), gc);
        unpack8(t > 0 ? *(const u32x4*)(pr - NIN + c8) : z4, up); unpack8(t > 0 ? *(const u32x4*)(pr - NIN + 1024 + c8) : z4, gcp);
        unpack8(t < L - 1 ? *(const u32x4*)(pr + NIN + c8) : z4, un); unpack8(t < L - 1 ? *(const u32x4*)(pr + NIN + 1024 + c8) : z4, gcn);
#pragma unroll
        for (int i = 0; i < 8; ++i) o[i] = gb[i] * (cw0[i] * (gcp[i] * up[i]) + cw1[i] * (gc[i] * u[i]) + cw2[i] * (gcn[i] * un[i]));
        *(u32x4*)(ACT + (size_t)m * D + c8) = pack8(o);
        float y0[8], y1[8], r[8], k[8], v[8], g[8];
        unpack8(*(const u32x4*)(Y0 + (size_t)m * 512 + c8), y0); unpack8(*(const u32x4*)(Y1 + (size_t)m * 512 + c8), y1);
        unpack8(*(const u32x4*)(pr + 1536 + c8), r); unpack8(*(const u32x4*)(pr + 2048 + c8), k); unpack8(*(const u32x4*)(pr + 2560 + c8), v);
        unpack8(*(const u32x4*)(Q2 + (size_t)m * 512 + c8), g);
        float s = 0.f, bs = 0.f;
#pragma unroll
        for (int i = 0; i < 8; ++i) { y0[i] += y1[i]; s += y0[i]; bs += r[i] * k[i] * rk[i]; }
        s += __shfl_xor(s, 1); s += __shfl_xor(s, 2); s += __shfl_xor(s, 4);
        bs += __shfl_xor(bs, 1); bs += __shfl_xor(bs, 2); bs += __shfl_xor(bs, 4);
        const float mu = s * (1.0f / 64.0f); float q = 0.f;
#pragma unroll
        for (int i = 0; i < 8; ++i) { y0[i] -= mu; q += y0[i] * y0[i]; }
        q += __shfl_xor(q, 1); q += __shfl_xor(q, 2); q += __shfl_xor(q, 4);
        const float rstd = rsqrtf(q * (1.0f / 64.0f) + 64e-5f);
#pragma unroll
        for (int i = 0; i < 8; ++i) o[i] = (y0[i] * rstd * lng[i] + lnb[i] + bs * v[i]) * g[i];
        *(u32x4*)(ACT + (size_t)m * D + 512 + c8) = pack8(o);
    }
}

__device__ __forceinline__ void ph_norm2_router(CArgs& a, int l, int Mrows, LAS unsigned char* lds, int tid, int wave, int lane) {
    LAS float* rtT = (LAS float*)lds;
    const float* R = a.in[I_ROUTER] + (size_t)l * D * 16;
    __syncthreads();
    for (int i = tid; i < D * 16; i += NTHREADS) { const int c = i >> 4, e = i & 15; rtT[e * 1024 + c] = R[i]; }
    __syncthreads();
    const int gw = blockIdx.x * NWAVES + wave, NGW = gridDim.x * NWAVES;
    const float* mod = (const float*)(a.ws + WS_MOD); bf16* ACT = (bf16*)(a.ws + WS_ACT); float* AFF = (float*)(a.ws + WS_AFF);
    const float* XC = (const float*)(a.ws + WS_XC);
    const bool b5 = (lane & 32) != 0, b4 = (lane & 16) != 0, b3 = (lane & 8) != 0, b2 = (lane & 4) != 0;
    const int myexp = (b5 ? 8 : 0) | (b4 ? 4 : 0) | (b3 ? 2 : 0) | (b2 ? 1 : 0);
    for (int grp = gw; grp < Mrows / 4; grp += NGW) {
        f32x4 h[4][4];
#pragma unroll
        for (int rr = 0; rr < 4; ++rr) { const int m = 4 * grp + rr;
            const float* xr = m < ML ? a.out + (size_t)m * D : XC + (size_t)(m - ML) * D;
#pragma unroll
            for (int j = 0; j < 4; ++j) h[rr][j] = *((const f32x4*)xr + lane + 64 * j); }
#pragma unroll
        for (int rr = 0; rr < 4; ++rr) { const int m = 4 * grp + rr; f32x4 v[4];
#pragma unroll
            for (int j = 0; j < 4; ++j) v[j] = h[rr][j];
            const float rstd = row_rstd(v); const float* ms = mod + (size_t)(l * 5 + sample_of(m)) * 6144;
            norm_mod_store(v, rstd, a.in[I_N2G] + l * D, ms + 4096, ms + 3072, ACT + (size_t)m * D, lane, h[rr]); }
        float q1v[4];
#define RT_DOT(e_, out_) do { f32x4 rv_[4]; _Pragma("unroll") for (int j = 0; j < 4; ++j) rv_[j] = *(const LAS f32x4*)(rtT + (e_) * 1024 + 4 * lane + 256 * j); \
            _Pragma("unroll") for (int rr = 0; rr < 4; ++rr) { float acc_ = 0.f; _Pragma("unroll") for (int j = 0; j < 4; ++j) acc_ += (h[rr][j].x * rv_[j].x + h[rr][j].y * rv_[j].y) + (h[rr][j].z * rv_[j].z + h[rr][j].w * rv_[j].w); out_[rr] = acc_; } } while (0)
        {
            float q2v[2][4];
#pragma unroll
            for (int c = 0; c < 2; ++c) {
                float q4v[2][4];
#pragma unroll
                for (int bs = 0; bs < 2; ++bs) {
                    float q8v[2][4];
#pragma unroll
                    for (int as = 0; as < 2; ++as) { const int k8 = c + 2 * bs + 4 * as; float pa[4], pb[4];
                        RT_DOT(k8, pa); RT_DOT(k8 + 8, pb);
#pragma unroll
                        for (int rr = 0; rr < 4; ++rr) { const float keep = b5 ? pb[rr] : pa[rr], send = b5 ? pa[rr] : pb[rr]; q8v[as][rr] = keep + __shfl_xor(send, 32); }
                        asm volatile("" ::: "memory"); }
#pragma unroll
                    for (int rr = 0; rr < 4; ++rr) { const float keep = b4 ? q8v[1][rr] : q8v[0][rr], send = b4 ? q8v[0][rr] : q8v[1][rr]; q4v[bs][rr] = keep + __shfl_xor(send, 16); }
                }
#pragma unroll
                for (int rr = 0; rr < 4; ++rr) { const float keep = b3 ? q4v[1][rr] : q4v[0][rr], send = b3 ? q4v[0][rr] : q4v[1][rr]; q2v[c][rr] = keep + __shfl_xor(send, 8); }
            }
#pragma unroll
            for (int rr = 0; rr < 4; ++rr) { const float keep = b2 ? q2v[1][rr] : q2v[0][rr], send = b2 ? q2v[0][rr] : q2v[1][rr]; q1v[rr] = keep + __shfl_xor(send, 4); }
        }
#undef RT_DOT
#pragma unroll
        for (int rr = 0; rr < 4; ++rr) {
            float q1 = q1v[rr];
            q1 += __shfl_xor(q1, 2); q1 += __shfl_xor(q1, 1);
            float mx = q1; mx = fmaxf(mx, __shfl_xor(mx, 4)); mx = fmaxf(mx, __shfl_xor(mx, 8)); mx = fmaxf(mx, __shfl_xor(mx, 16)); mx = fmaxf(mx, __shfl_xor(mx, 32));
            const float ex = __expf(q1 - mx);
            float den = ex; den += __shfl_xor(den, 4); den += __shfl_xor(den, 8); den += __shfl_xor(den, 16); den += __shfl_xor(den, 32);
            if ((lane & 3) == 0) AFF[(size_t)(4 * grp + rr) * 16 + myexp] = ex * __builtin_amdgcn_rcpf(den);
        }
    }
}

__device__ __forceinline__ int block_excl_scan(int v, LAS int* tmp, int wave, int lane, int& total) {
    int inc = v;
#pragma unroll
    for (int o = 1; o < 64; o <<= 1) { const int t = __shfl_up(inc, o); if (lane >= o) inc += t; }
    if (lane == 63) tmp[wave] = inc;
    __syncthreads();
    int base = 0, tot = 0;
#pragma unroll
    for (int w = 0; w < NWAVES; ++w) { const int x = tmp[w]; if (w < wave) base += x; tot += x; }
    __syncthreads();
    total = tot; return base + inc - v;
}
__device__ __forceinline__ void ph_topk(CArgs& a, int l, LAS unsigned char* lds, int tid, int wave, int lane) {
    LAS unsigned* keys = (LAS unsigned*)lds;
    LAS int* hist = (LAS int*)(lds + 32768);
    LAS int* sfx = hist + 256;
    LAS int* tmp = sfx + 264;
    LAS int* bc = tmp + 8;
    const float* AFF = (const float*)(a.ws + WS_AFF); int* INV = (int*)(a.ws + WS_INV); int* IDX = (int*)(a.ws + WS_IDX);
    const int nitems = l == 0 ? 128 : 64, RPE = l == 0 ? RPE0 : RPE1;
    for (int item = blockIdx.x; item < nitems; item += gridDim.x) {
        const bool lat = item < 64; const int b = (item & 63) >> 4, e = item & 15;
        const int T = lat ? SEQ : CTXL, cap = T / 8, row0 = lat ? b * SEQ : ML + b * CTXL, segbase = lat ? b * 1024 : 4096 + b * 32;
        __syncthreads();
        for (int i = tid; i < T; i += NTHREADS) keys[i] = __float_as_uint(AFF[(size_t)(row0 + i) * 16 + e]);
        unsigned prefix = 0u, mask = 0u; int kk = cap;
        for (int pass = 0; pass < 4; ++pass) {
            const int shift = 24 - 8 * pass;
            if (tid < 256) hist[tid] = 0;
            __syncthreads();
            for (int i = tid; i < T; i += NTHREADS) { const unsigned k = keys[i]; if ((k & mask) == prefix) __hip_atomic_fetch_add(&hist[(k >> shift) & 255u], 1, __ATOMIC_RELAXED, __HIP_MEMORY_SCOPE_WORKGROUP); }
            __syncthreads();
            if (tid < 256) { int s = 0; for (int q = tid; q < 256; ++q) s += hist[q]; sfx[tid] = s; } else if (tid == 256) sfx[256] = 0;
            __syncthreads();
            if (tid < 256) { const int s0 = sfx[tid], s1 = sfx[tid + 1]; if (s0 >= kk && s1 < kk) { bc[0] = tid; bc[1] = kk - s1; } }
            __syncthreads();
            prefix |= ((unsigned)bc[0]) << shift; mask |= 0xffu << shift; kk = bc[1];
            __syncthreads();
        }
        const unsigned thr = prefix; const int need = kk;
        const int i0 = 16 * tid; int ceq = 0;
        unsigned kv[16];
#pragma unroll
        for (int i = 0; i < 16; ++i) { kv[i] = (i0 + i < T) ? keys[i0 + i] : 0u; ceq += (i0 + i < T && kv[i] == thr) ? 1 : 0; }
        int tot; int eqr = block_excl_scan(ceq, tmp, wave, lane, tot);
        int nsel = 0; unsigned selmask = 0u;
#pragma unroll
        for (int i = 0; i < 16; ++i) { bool sel = false; if (i0 + i < T) { if (kv[i] > thr) sel = true; else if (kv[i] == thr) { sel = eqr < need; ++eqr; } } if (sel) { selmask |= 1u << i; ++nsel; } }
        int slot = segbase + block_excl_scan(nsel, tmp, wave, lane, tot);
#pragma unroll
        for (int i = 0; i < 16; ++i) if (i0 + i < T) { const int row = row0 + i0 + i; if (selmask & (1u << i)) { IDX[e * RPE + slot] = row; INV[(size_t)row * 16 + e] = slot; ++slot; } else INV[(size_t)row * 16 + e] = -1; }
        if (l == 0 && lat && b == 0 && tid < 128) IDX[e * RPE + 4224 + tid] = 0;
    }
}

__device__ __forceinline__ void ph_gather(CArgs& a, int l, int wave, int lane) {
    const int gw = blockIdx.x * NWAVES + wave, NGW = gridDim.x * NWAVES;
    const bf16* ACT = (const bf16*)(a.ws + WS_ACT); bf16* XIN = (bf16*)(a.ws + WS_Q2); const int* IDX = (const int*)(a.ws + WS_IDX);
    const int nrows = 16 * (l == 0 ? RPE0 : RPE1);
    for (int r = gw; r < nrows; r += NGW) {
        const int src = IDX[r];
        const u32x4* s = (const u32x4*)(ACT + (size_t)src * D) + lane; u32x4* d = (u32x4*)(XIN + (size_t)r * D) + lane;
        const u32x4 x0 = s[0], x1 = s[64]; d[0] = x0; d[64] = x1;
    }
}

template <bool NEXTNORM>
__device__ __forceinline__ void ph_combine(CArgs& a, int l, int Mrows, int wave, int lane) {
    const int gw = blockIdx.x * NWAVES + wave, NGW = gridDim.x * NWAVES;
    const float* mod = (const float*)(a.ws + WS_MOD); bf16* ACT = (bf16*)(a.ws + WS_ACT); const float* AFF = (const float*)(a.ws + WS_AFF);
    const int* INV = (const int*)(a.ws + WS_INV); const bf16* YE = (const bf16*)(a.ws + WS_Q2); float* XC = (float*)(a.ws + WS_XC);
    const int RPE = l == 0 ? RPE0 : RPE1;
    for (int grp = gw; grp < Mrows / 4; grp += NGW) {
        f32x4 acc[4][4], xv[4][4]; int myinv[4]; float myaff[4]; unsigned long long msk[4];
#pragma unroll
        for (int rr = 0; rr < 4; ++rr) { const int m = 4 * grp + rr;
            myinv[rr] = lane < 16 ? INV[(size_t)m * 16 + lane] : -1; myaff[rr] = lane < 16 ? AFF[(size_t)m * 16 + lane] : 0.f;
            const float* xr = m < ML ? a.out + (size_t)m * D : XC + (size_t)(m - ML) * D;
#pragma unroll
            for (int j = 0; j < 4; ++j) { xv[rr][j] = *((const f32x4*)xr + lane + 64 * j); acc[rr][j] = (f32x4){0.f, 0.f, 0.f, 0.f}; } }
#pragma unroll
        for (int rr = 0; rr < 4; ++rr) msk[rr] = __ballot(myinv[rr] >= 0);
        while ((msk[0] | msk[1] | msk[2] | msk[3]) != 0ull) {
            unsigned long long w[4][4]; float gt[4];
#pragma unroll
            for (int rr = 0; rr < 4; ++rr) {
                gt[rr] = 0.f;
#pragma unroll
                for (int j = 0; j < 4; ++j) w[rr][j] = 0ull;
                if (msk[rr] != 0ull) { const int e = __builtin_ctzll(msk[rr]); msk[rr] &= msk[rr] - 1ull;
                    const int slot = __builtin_amdgcn_readlane(myinv[rr], e); gt[rr] = __builtin_bit_cast(float, __builtin_amdgcn_readlane(__builtin_bit_cast(int, myaff[rr]), e));
                    const unsigned long long* yr = (const unsigned long long*)(YE + ((size_t)e * RPE + slot) * D) + lane;
#pragma unroll
                    for (int j = 0; j < 4; ++j) w[rr][j] = yr[64 * j]; }
            }
#pragma unroll
            for (int rr = 0; rr < 4; ++rr)
#pragma unroll
                for (int j = 0; j < 4; ++j) { const unsigned lo = (unsigned)w[rr][j], hi = (unsigned)(w[rr][j] >> 32); const float g = gt[rr];
                    acc[rr][j].x += g * bflo(lo); acc[rr][j].y += g * bfhi(lo); acc[rr][j].z += g * bflo(hi); acc[rr][j].w += g * bfhi(hi); }
        }
#pragma unroll
        for (int rr = 0; rr < 4; ++rr) { const int m = 4 * grp + rr;
            float* xr = m < ML ? a.out + (size_t)m * D : XC + (size_t)(m - ML) * D;
            const int smp = sample_of(m); const float* ms = mod + (size_t)(l * 5 + smp) * 6144;
            f32x4 v[4], h[4];
#pragma unroll
            for (int j = 0; j < 4; ++j) { const f32x4 g2 = *((const f32x4*)(ms + 5120) + lane + 64 * j); v[j] = xv[rr][j] + g2 * acc[rr][j]; *((f32x4*)xr + lane + 64 * j) = v[j]; }
            if (NEXTNORM) {
                const float rstd = row_rstd(v); const float* ms1 = mod + (size_t)(1 * 5 + smp) * 6144;
                norm_mod_store(v, rstd, a.in[I_N1G] + D, ms1 + 1024, ms1, ACT + (size_t)m * D, lane, h);
            }
        }
    }
}

__device__ __forceinline__ f32x16 mfma32(bf16x8 a, bf16x8 b, f32x16 c) { return __builtin_amdgcn_mfma_f32_32x32x16_bf16(a, b, c, 0, 0, 0); }
__device__ __forceinline__ float logsigmoidf_(float x) { return fminf(x, 0.f) - __logf(1.0f + __expf(-fabsf(x))); }

#define GLA_CG(n) ((n) < 4 ? 512 + 4 * b + (d == 0 ? (n) : 3 - (n)) : 128 * b + (d == 0 ? (n) - 4 : 127 - ((n) - 4)))
__device__ __forceinline__ void ph_l1_prep(CArgs& a, LAS unsigned char* lds, int tid, int wave, int lane) {
    const bf16* P = (const bf16*)(a.ws + WS_P);
    const int G = gridDim.x, bid = blockIdx.x;
    {
        bf16* QF = (bf16*)(a.ws + WS_QF); bf16* KF = (bf16*)(a.ws + WS_KF); bf16* VF = (bf16*)(a.ws + WS_VF);
        const int nskip = (G > 64 && 1056 % G != 0) ? (1056 % G) : 0;
        const int gw = (bid - nskip) * NWAVES + wave, NGW = (G - nskip) * NWAVES;
        const int tok = lane & 31, hf = lane >> 5;
        LAS bf16* Tv = (LAS bf16*)(lds + wave * 4608);
        __syncthreads();
        for (int rep_ = 0; rep_ < REPS(6); ++rep_)
        for (int it = (bid >= nskip ? gw : 1056 * 8); it < 1056 * 8; it += NGW) {
            const int tc = it >> 3, h = it & 7;
            const bool lat = tc < 1024; const int b = lat ? (tc >> 8) : ((tc - 1024) >> 3), kc = lat ? (tc & 255) : (256 + ((tc - 1024) & 7));
            const size_t m = (size_t)32 * tc + tok;
#pragma unroll
            for (int which = 0; which < 2; ++which) {
                if (which == 1 && !lat) break;
                const bf16* src = P + m * NIN + (which == 0 ? 512 : 0) + h * 64 + 32 * hf;
                const float* gn = a.in[which == 0 ? I_KNG : I_QNG] + 32 * hf;
                float f[4][8]; float ss = 0.f;
#pragma unroll
                for (int e = 0; e < 4; ++e) { unpack8(*(const u32x4*)(src + 8 * e), f[e]);
#pragma unroll
                    for (int i = 0; i < 8; ++i) ss += f[e][i] * f[e][i]; }
                ss += __shfl_xor(ss, 32);
                const float rstd = rsqrtf(ss * (1.0f / 64.0f) + 1e-6f) * (which == 1 ? 0.125f * 1.44269504f : 1.0f);
                bf16* dst = which == 0 ? KF + ((size_t)((b * 8 + h) * 264 + kc) * 4) * 512 : QF + ((size_t)((b * 8 + h) * 256 + kc) * 4) * 512;
#pragma unroll
                for (int e = 0; e < 4; ++e) { float o[8];
#pragma unroll
                    for (int i = 0; i < 8; ++i) o[i] = f[e][i] * rstd * gn[8 * e + i];
                    const int s = 2 * hf + (e >> 1), hp = e & 1;
                    *(u32x4*)(dst + ((size_t)s * 64 + tok + 32 * hp) * 8) = pack8(o); }
            }
            { const bf16* src = P + m * NIN + 1024 + h * 64 + 32 * hf;
#pragma unroll
              for (int e = 0; e < 4; ++e) *(LAS u32x4*)(Tv + tok * 72 + 32 * hf + 8 * e) = *(const u32x4*)(src + 8 * e); }
            asm volatile("s_waitcnt lgkmcnt(0)" ::: "memory");
            bf16* vdst = VF + ((size_t)((b * 8 + h) * 264 + kc) * 4) * 512;
#pragma unroll
            for (int mt = 0; mt < 2; ++mt)
#pragma unroll
                for (int s = 0; s < 2; ++s) { u32x4 w; unsigned o[8];
#pragma unroll
                    for (int j = 0; j < 8; ++j) o[j] = Tv[(16 * s + 8 * (j >> 2) + 4 * hf + (j & 3)) * 72 + 32 * mt + tok];
                    w.x = o[0] | (o[1] << 16); w.y = o[2] | (o[3] << 16); w.z = o[4] | (o[5] << 16); w.w = o[6] | (o[7] << 16);
                    *(u32x4*)(vdst + ((size_t)(mt * 2 + s) * 64 + lane) * 8) = w; }
            asm volatile("s_waitcnt lgkmcnt(0)" ::: "memory");
        }
    }
    {
        constexpr int PT = 72;
        LAS float* ga = (LAS float*)lds;
        LAS float* bcum = ga + 1024;
        LAS float* tot = bcum + 64 * 256;
        LAS bf16* Qd = (LAS bf16*)(tot + 512);
        LAS bf16* Ki = Qd + 64 * PT; LAS bf16* Ks = Ki + 64 * PT;
        LAS bf16* VT = Ks + 64 * PT;
        LAS bf16* As = VT + 128 * PT;
        bf16* GQD = (bf16*)(a.ws + WS_GQD); bf16* KLOC = (bf16*)(a.ws + WS_KLOC); float* GDEC = (float*)(a.ws + WS_GDEC); const float* rope = (const float*)(a.ws + WS_ROPE);
        const int lr = lane & 15, lq = lane >> 4;
        for (int rep_ = 0; rep_ < REPS(7); ++rep_)
        for (int item = bid; item < 528 * 2; item += G) {
            const int cg = item >> 1, d = item & 1; const bool lat = cg < 512;
            bf16* O = (bf16*)(a.ws + (d ? WS_Y1 : WS_Y0));
            u32x4 pa, pb, pv0, pv1;
#define GLA1_LOAD(h_) do { const int t2_ = tid & 255, i_ = t2_ >> 2, part_ = (t2_ >> 1) & 1, c_ = t2_ & 1; \
                const bf16* pr_ = P + ((size_t)64 * cg + i_) * NIN + (tid >= 256 ? 1792 : 1536) + (h_) * 64 + 32 * part_ + 8 * c_; pa = *(const u32x4*)pr_; pb = *(const u32x4*)(pr_ + 16); \
                pv0 = *(const u32x4*)(P + ((size_t)64 * cg + (tid >> 4)) * NIN + 2048 + (h_) * 128 + 8 * (tid & 15)); pv1 = *(const u32x4*)(P + ((size_t)64 * cg + 32 + (tid >> 4)) * NIN + 2048 + (h_) * 128 + 8 * (tid & 15)); } while (0)
            GLA1_LOAD(0);
            __syncthreads();
            { const int i = tid >> 3, r2 = (tid & 7) * 2; const unsigned w = *(const unsigned*)(P + ((size_t)64 * cg + i) * NIN + 3072 + r2); ga[i * 16 + r2] = bflo(w); ga[i * 16 + r2 + 1] = bfhi(w); }
            __syncthreads();
            { const int c = tid & 255, hf = tid >> 8; float au[16];
#pragma unroll
                for (int r = 0; r < 16; ++r) au[r] = a.in[I_GAUP][(d * 16 + r) * 256 + c];
                const float ab = a.in[I_GAB][d * 256 + c]; float run = 0.f;
#pragma unroll 4
                for (int ii = 0; ii < 32; ++ii) { const int i = d == 0 ? 32 * hf + ii : 32 * hf + 31 - ii; float x = ab;
#pragma unroll
                    for (int r4 = 0; r4 < 4; ++r4) { const f32x4 gv = *(const LAS f32x4*)(ga + i * 16 + 4 * r4); x += (gv.x * au[4 * r4] + gv.y * au[4 * r4 + 1]) + (gv.z * au[4 * r4 + 2] + gv.w * au[4 * r4 + 3]); }
                    run += logsigmoidf_(x) * (1.0f / 16.0f); bcum[i * 256 + c] = run; }
                tot[hf * 256 + c] = run; }
            __syncthreads();
            { const int c = tid & 255, hf = tid >> 8; const bool mine = d == 0 ? (hf == 1) : (hf == 0); const float off = tot[(d == 0 ? 0 : 1) * 256 + c];
                if (mine) for (int ii = 0; ii < 32; ++ii) bcum[(32 * hf + ii) * 256 + c] += off; }
            if (tid < 256) GDEC[(size_t)(cg * 2 + d) * 256 + tid] = __expf(tot[tid] + tot[256 + tid]);
            for (int h = 0; h < 4; ++h) {
                LDS_BARRIER();
                {
                    const int t2 = tid & 255, i = t2 >> 2, part = (t2 >> 1) & 1, c = t2 & 1; const bool isk = tid >= 256;
                    const size_t m = (size_t)64 * cg + i;
                    float x1[8], x2[8]; unpack8(pa, x1); unpack8(pb, x2);
                    if (lat) { const int t = (int)(m & (SEQ - 1)); const int pos = part == 0 ? (t >> 6) : (t & 63); float cs0[8], cs1[8]; load8f(rope + (pos * 16 + 8 * c) * 2, cs0); load8f(rope + (pos * 16 + 8 * c) * 2 + 8, cs1);
#pragma unroll
                        for (int e = 0; e < 8; ++e) { const float c_ = e < 4 ? cs0[2 * e] : cs1[2 * e - 8], s_ = e < 4 ? cs0[2 * e + 1] : cs1[2 * e - 7]; const float ya = x1[e] * c_ - x2[e] * s_, yb = x1[e] * s_ + x2[e] * c_; x1[e] = ya; x2[e] = yb; } }
                    const int j1 = 32 * part + 8 * c, j2 = j1 + 16; float b1[8], b2[8];
                    { const LAS float* bp = bcum + i * 256 + h * 64; const f32x4 u0 = *(const LAS f32x4*)(bp + j1), u1 = *(const LAS f32x4*)(bp + j1 + 4), u2 = *(const LAS f32x4*)(bp + j2), u3 = *(const LAS f32x4*)(bp + j2 + 4);
                      b1[0] = u0.x; b1[1] = u0.y; b1[2] = u0.z; b1[3] = u0.w; b1[4] = u1.x; b1[5] = u1.y; b1[6] = u1.z; b1[7] = u1.w; b2[0] = u2.x; b2[1] = u2.y; b2[2] = u2.z; b2[3] = u2.w; b2[4] = u3.x; b2[5] = u3.y; b2[6] = u3.z; b2[7] = u3.w; }
                    if (!isk) { float o1[8], o2[8];
#pragma unroll
                        for (int e = 0; e < 8; ++e) { o1[e] = x1[e] * 0.125f * __expf(b1[e]); o2[e] = x2[e] * 0.125f * __expf(b2[e]); }
                        *(LAS u32x4*)(Qd + i * PT + j1) = pack8(o1); *(LAS u32x4*)(Qd + i * PT + j2) = pack8(o2);
                    } else { float o1[8], o2[8];
#pragma unroll
                        for (int e = 0; e < 8; ++e) { o1[e] = x1[e] * __expf(-b1[e]); o2[e] = x2[e] * __expf(-b2[e]); }
                        *(LAS u32x4*)(Ki + i * PT + j1) = pack8(o1); *(LAS u32x4*)(Ki + i * PT + j2) = pack8(o2);
#pragma unroll
                        for (int e0 = 0; e0 < 8; ++e0) { const int e = (e0 + 2 * (2 * part + c)) & 7;
                            const float bC1 = tot[h * 64 + j1 + e] + tot[256 + h * 64 + j1 + e], bC2 = tot[h * 64 + j2 + e] + tot[256 + h * 64 + j2 + e];
                            float xa = x1[0], xb = x2[0], ba = b1[0], bb = b2[0];
#pragma unroll
                            for (int q = 1; q < 8; ++q) { xa = (e == q) ? x1[q] : xa; xb = (e == q) ? x2[q] : xb; ba = (e == q) ? b1[q] : ba; bb = (e == q) ? b2[q] : bb; }
                            Ks[(j1 + e) * PT + i] = (bf16)f2bf(xa * __expf(bC1 - ba)); Ks[(j2 + e) * PT + i] = (bf16)f2bf(xb * __expf(bC2 - bb)); }
                    }
#pragma unroll
                    for (int rep = 0; rep < 2; ++rep) { const int vi = tid + 512 * rep, tk = vi >> 4, dg = vi & 15; const u32x4 w = rep == 0 ? pv0 : pv1;
                        const unsigned wv[4] = {w.x, w.y, w.z, w.w};
#pragma unroll
                        for (int q = 0; q < 8; ++q) { const int qq = (q + dg) & 7; const unsigned ww = (qq & 4) ? ((qq & 2) ? w.w : w.z) : ((qq & 2) ? w.y : w.x); (void)wv;
                            VT[(8 * dg + qq) * PT + tk] = (bf16)((qq & 1) ? (ww >> 16) : (ww & 0xffffu)); } }
                }
                if (h + 1 < 4) GLA1_LOAD(h + 1);
                LDS_BARRIER();
                const size_t tile = (size_t)(cg * 2 + d) * 4 + h;
                if (lat) {
#pragma unroll
                    for (int tt = 0; tt < 2; ++tt) {
                        const int tl = 2 * wave + tt, mi = tl >> 2, nj = tl & 3;
                        f32x4 acc = (f32x4){0.f, 0.f, 0.f, 0.f};
                        const bool dead = d == 0 ? (nj > mi) : (nj < mi);
                        if (!dead) {
#pragma unroll
                            for (int ks = 0; ks < 2; ++ks) acc = mfma16(*(const LAS bf16x8*)(Qd + (16 * mi + lr) * PT + 32 * ks + 8 * lq), *(const LAS bf16x8*)(Ki + (16 * nj + lr) * PT + 32 * ks + 8 * lq), acc);
                        }
#pragma unroll
                        for (int rg = 0; rg < 4; ++rg) { const int i = 16 * mi + 4 * lq + rg, j = 16 * nj + lr; const bool keep = d == 0 ? (j <= i) : (j >= i); As[i * PT + j] = (bf16)f2bf(keep ? acc[rg] : 0.f); }
                    }
                    *((u32x4*)(GQD + tile * 4096) + tid) = *(const LAS u32x4*)(Qd + (tid >> 3) * PT + 8 * (tid & 7));
                }
#pragma unroll
                for (int mt = 0; mt < 4; ++mt) { f32x4 acc = (f32x4){0.f, 0.f, 0.f, 0.f};
#pragma unroll
                    for (int ks = 0; ks < 2; ++ks) acc = mfma16(*(const LAS bf16x8*)(Ks + (16 * mt + lr) * PT + 32 * ks + 8 * lq), *(const LAS bf16x8*)(VT + (16 * wave + lr) * PT + 32 * ks + 8 * lq), acc);
                    u32x2 w; w.x = pk2(acc[0], acc[1]); w.y = pk2(acc[2], acc[3]);
                    *(u32x2*)(KLOC + tile * 8192 + (16 * wave + lr) * 64 + 16 * mt + 4 * lq) = w; }
                if (lat) {
                    LDS_BARRIER();
#pragma unroll
                    for (int ni = 0; ni < 4; ++ni) { f32x4 acc = (f32x4){0.f, 0.f, 0.f, 0.f};
#pragma unroll
                        for (int ks = 0; ks < 2; ++ks) acc = mfma16(*(const LAS bf16x8*)(VT + (16 * wave + lr) * PT + 32 * ks + 8 * lq), *(const LAS bf16x8*)(As + (16 * ni + lr) * PT + 32 * ks + 8 * lq), acc);
                        u32x2 w; w.x = pk2(acc[0], acc[1]); w.y = pk2(acc[2], acc[3]);
                        *(u32x2*)(O + ((size_t)64 * cg + 16 * ni + lr) * 512 + h * 128 + 16 * wave + 4 * lq) = w; }
                }
            }
        }
    }
}

#undef GLA1_LOAD
__device__ __forceinline__ void ph_gla_scan(CArgs& a, int tid) {
    const bf16* KLOC = (const bf16*)(a.ws + WS_KLOC); const float* GDEC = (const float*)(a.ws + WS_GDEC); bf16* GST = (bf16*)(a.ws + WS_GST);
    for (int gid = blockIdx.x * NTHREADS + tid; gid < 32 * 4096; gid += gridDim.x * NTHREADS) {
        const int sq = gid >> 12, e2 = gid & 4095, b = sq >> 3, d = (sq >> 2) & 1, h = sq & 3, dk = 2 * (e2 & 31);
        float S0 = 0.f, S1 = 0.f;
#pragma unroll 1
        for (int n0 = 0; n0 < 132; n0 += 6) {
            unsigned kl[6]; f32x2 dc[6];
#pragma unroll
            for (int u = 0; u < 6; ++u) { const int cg = GLA_CG(n0 + u); const size_t tile = (size_t)(cg * 2 + d) * 4 + h; kl[u] = *(const unsigned*)(KLOC + tile * 8192 + 2 * e2); dc[u] = *(const f32x2*)(GDEC + (size_t)(cg * 2 + d) * 256 + h * 64 + dk); }
#pragma unroll
            for (int u = 0; u < 6; ++u) { const int n = n0 + u; const int cg = GLA_CG(n);
                if (n >= 4) *(unsigned*)(GST + ((size_t)(cg * 2 + d) * 4 + h) * 8192 + 2 * e2) = pk2(S0, S1);
                S0 = S0 * dc[u].x + bflo(kl[u]); S1 = S1 * dc[u].y + bfhi(kl[u]); }
        }
    }
}

__device__ __forceinline__ void ph_nat_task(CArgs& a, const LAS float* rpb, float m2, int b, int h, int r, int qt, int lane) {
    const bf16x8* QF = (const bf16x8*)(a.ws + WS_QF); const bf16x8* KF = (const bf16x8*)(a.ws + WS_KF); const bf16x8* VF = (const bf16x8*)(a.ws + WS_VF);
    bf16* ACT = (bf16*)(a.ws + WS_ACT);
    const int hf = lane >> 5, ql = lane & 31;
    const int rs = min(max(r - 4, 0), 120);
#define NAT_KC(ch_) ((ch_) < 16 ? 2 * (rs + ((ch_) >> 1)) + ((ch_) & 1) : 256 + ((ch_) - 16))
#define NAT_LOAD(ch_) do { const size_t kb_ = (size_t)((b * 8 + h) * 264 + NAT_KC(ch_)) * 4 * 64; \
        _Pragma("unroll") for (int s = 0; s < 4; ++s) kfn[s] = KF[kb_ + s * 64 + lane]; \
        _Pragma("unroll") for (int mt = 0; mt < 2; ++mt) _Pragma("unroll") for (int s = 0; s < 2; ++s) vfn[mt][s] = VF[kb_ + (mt * 2 + s) * 64 + lane]; } while (0)
    {
        bf16x8 qf[4];
#pragma unroll
        for (int s = 0; s < 4; ++s) qf[s] = QF[((size_t)((b * 8 + h) * 256 + 2 * r + qt) * 4 + s) * 64 + lane];
        f32x16 Oa[2]; float lrun = 0.f;
#pragma unroll
        for (int mt = 0; mt < 2; ++mt)
#pragma unroll
            for (int i = 0; i < 16; ++i) Oa[mt][i] = 0.f;
        const int c = 32 * qt + ql, cs = min(max(c - 8, 0), 48);
        unsigned vmask[2]; int dcb[2];
#pragma unroll
        for (int hc2 = 0; hc2 < 2; ++hc2) { unsigned mk = 0u;
#pragma unroll
            for (int rg = 0; rg < 16; ++rg) { const int kcol = 32 * hc2 + (rg & 3) + 8 * (rg >> 2) + 4 * hf; mk |= (kcol >= cs && kcol < cs + 16) ? (1u << rg) : 0u; }
            vmask[hc2] = mk; dcb[hc2] = 32 * hc2 + 4 * hf - c + 15; }
        bf16x8 kfn[4], vfn[2][2], kfm[4], vfm[2][2];
#define NAT_LOAD2(ch_) do { const size_t kb_ = (size_t)((b * 8 + h) * 264 + NAT_KC(ch_)) * 4 * 64; \
        _Pragma("unroll") for (int s = 0; s < 4; ++s) kfm[s] = KF[kb_ + s * 64 + lane]; \
        _Pragma("unroll") for (int mt = 0; mt < 2; ++mt) _Pragma("unroll") for (int s = 0; s < 2; ++s) vfm[mt][s] = VF[kb_ + (mt * 2 + s) * 64 + lane]; } while (0)
        NAT_LOAD(0); NAT_LOAD2(1);
        for (int ch = 0; ch < 24; ++ch) {
            const bool local = ch < 16; const int wi = ch >> 1, hc = ch & 1;
            bf16x8 kf[4], vf[2][2];
#pragma unroll
            for (int s = 0; s < 4; ++s) { kf[s] = kfn[s]; kfn[s] = kfm[s]; }
#pragma unroll
            for (int mt = 0; mt < 2; ++mt)
#pragma unroll
                for (int s = 0; s < 2; ++s) { vf[mt][s] = vfn[mt][s]; vfn[mt][s] = vfm[mt][s]; }
            if (ch + 2 < 24) NAT_LOAD2(ch + 2);
            f32x16 S; const float sinit = local ? 0.f : -m2;
#pragma unroll
            for (int i = 0; i < 16; ++i) S[i] = sinit;
#pragma unroll
            for (int s = 0; s < 4; ++s) S = mfma32(kf[s], qf[s], S);
            __builtin_amdgcn_sched_barrier(0);
            float ps = 0.f;
            if (local) {
                const LAS float* bp = rpb + (h * 15 + (rs + wi - r + 7)) * 31 + dcb[hc]; const unsigned vm = vmask[hc];
#pragma unroll
                for (int rg = 0; rg < 16; ++rg) { const float p = __builtin_amdgcn_exp2f(S[rg] + bp[(rg & 3) + 8 * (rg >> 2)]);
                    S[rg] = __uint_as_float(__float_as_uint(p) & (unsigned)__builtin_amdgcn_sbfe((int)vm, rg, 1)); ps += S[rg]; }
            } else {
#pragma unroll
                for (int rg = 0; rg < 16; ++rg) { S[rg] = __builtin_amdgcn_exp2f(S[rg]); ps += S[rg]; }
            }
            lrun += ps;
            __builtin_amdgcn_sched_barrier(0);
            bf16x8 pf[2];
#pragma unroll
            for (int s = 0; s < 2; ++s) { u32x4 w; w.x = pk2(S[8 * s + 0], S[8 * s + 1]); w.y = pk2(S[8 * s + 2], S[8 * s + 3]); w.z = pk2(S[8 * s + 4], S[8 * s + 5]); w.w = pk2(S[8 * s + 6], S[8 * s + 7]); pf[s] = __builtin_bit_cast(bf16x8, w); }
#pragma unroll
            for (int mt = 0; mt < 2; ++mt)
#pragma unroll
                for (int s = 0; s < 2; ++s) Oa[mt] = mfma32(vf[mt][s], pf[s], Oa[mt]);
        }
        const float l = lrun + __shfl_xor(lrun, 32); const float inv = __builtin_amdgcn_rcpf(l);
        const size_t m = (size_t)b * SEQ + r * 64 + 32 * qt + ql;
#pragma unroll
        for (int mt = 0; mt < 2; ++mt)
#pragma unroll
            for (int g = 0; g < 4; ++g) { u32x2 w; w.x = pk2(Oa[mt][4 * g] * inv, Oa[mt][4 * g + 1] * inv); w.y = pk2(Oa[mt][4 * g + 2] * inv, Oa[mt][4 * g + 3] * inv);
                *(u32x2*)(ACT + m * D + h * 64 + 32 * mt + 8 * g + 4 * hf) = w; }
    }
}
#undef NAT_LOAD
#undef NAT_LOAD2
#undef NAT_KC
__device__ __forceinline__ void ph_nat_gla(CArgs& a, LAS unsigned char* lds, int tid, int wave, int lane) {
    const int G = gridDim.x, bid = blockIdx.x;
    for (int rep_ = 0; rep_ < REPS(8); ++rep_) ph_gla_scan(a, tid);
    LAS float* rpb = (LAS float*)lds; LAS float* red = rpb + 3840;
    __syncthreads();
    float gq = 0.f, gk = 0.f, rb = 0.f;
    if (tid < 64) { gq = fabsf(a.in[I_QNG][tid]); gk = fabsf(a.in[I_KNG][tid]); }
    for (int i = tid; i < 8 * 15 * 31; i += NTHREADS) rb = fmaxf(rb, fabsf(a.in[I_RPB][i]));
#pragma unroll
    for (int o = 1; o < 64; o <<= 1) { gq = fmaxf(gq, __shfl_xor(gq, o)); gk = fmaxf(gk, __shfl_xor(gk, o)); rb = fmaxf(rb, __shfl_xor(rb, o)); }
    if (lane == 0) { red[wave * 3] = gq; red[wave * 3 + 1] = gk; red[wave * 3 + 2] = rb; }
    __syncthreads();
    gq = 0.f; gk = 0.f; rb = 0.f;
#pragma unroll
    for (int w = 0; w < NWAVES; ++w) { gq = fmaxf(gq, red[w * 3]); gk = fmaxf(gk, red[w * 3 + 1]); rb = fmaxf(rb, red[w * 3 + 2]); }
    const float Mb = 8.0f * gq * gk * 1.02f + rb, m2 = Mb * 1.44269504f;
    for (int i = tid; i < 8 * 15 * 31; i += NTHREADS) rpb[i] = (a.in[I_RPB][i] - Mb) * 1.44269504f;
    __syncthreads();
    const int gwn = bid * NWAVES + wave, NW = G * NWAVES;
    LAS unsigned char* tile = lds + 16384 + wave * 8192;
    for (int rep_ = 0; rep_ < REPS(10); ++rep_) if (wave >= 4) moe_convert(a, 1, tile, gwn, NW, lane);
    for (int rep_ = 0; rep_ < REPS(9); ++rep_)
    if (G == 256) {
        const int xcd = bid & 7, j = (bid >> 3) * NWAVES + wave;
        for (int k = 0; k < 4; ++k) { const int bh = xcd + 8 * k; ph_nat_task(a, rpb, m2, bh >> 3, bh & 7, j >> 1, j & 1, lane); }
    } else {
        for (int t = gwn; t < 8192; t += NW) ph_nat_task(a, rpb, m2, t >> 11, (t >> 8) & 7, (t >> 1) & 127, t & 1, lane);
    }
    if (wave < 4) moe_convert(a, 1, tile, gwn, NW, lane);
}

__device__ __forceinline__ void ph_gla_readout(CArgs& a, LAS unsigned char* lds, int tid, int wave, int lane) {
    const bf16* P = (const bf16*)(a.ws + WS_P); const bf16* O0 = (const bf16*)(a.ws + WS_Y0); const bf16* O1 = (const bf16*)(a.ws + WS_Y1); bf16* ACT = (bf16*)(a.ws + WS_ACT);
    const bf16* GQD = (const bf16*)(a.ws + WS_GQD); const bf16* GST = (const bf16*)(a.ws + WS_GST);
    LAS float* part = (LAS float*)lds;
    const int lr = lane & 15, lq = lane >> 4;
    for (int cg = blockIdx.x; cg < 512; cg += gridDim.x) {
        f32x4 acc[4][4];
#pragma unroll
        for (int h = 0; h < 4; ++h) {
#pragma unroll
            for (int ni = 0; ni < 4; ++ni) { const size_t m = (size_t)64 * cg + 16 * ni + lr; const int col = h * 128 + 16 * wave + 4 * lq;
                const u32x2 w0 = *(const u32x2*)(O0 + m * 512 + col), w1 = *(const u32x2*)(O1 + m * 512 + col);
                acc[h][ni] = (f32x4){bflo(w0.x) + bflo(w1.x), bfhi(w0.x) + bfhi(w1.x), bflo(w0.y) + bflo(w1.y), bfhi(w0.y) + bfhi(w1.y)}; }
#pragma unroll
            for (int d = 0; d < 2; ++d) { const size_t tile = (size_t)(cg * 2 + d) * 4 + h;
                bf16x8 af[2];
#pragma unroll
                for (int ks = 0; ks < 2; ++ks) af[ks] = *(const bf16x8*)(GST + tile * 8192 + (16 * wave + lr) * 64 + 32 * ks + 8 * lq);
#pragma unroll
                for (int ni = 0; ni < 4; ++ni)
#pragma unroll
                    for (int ks = 0; ks < 2; ++ks) acc[h][ni] = mfma16(af[ks], *(const bf16x8*)(GQD + tile * 4096 + (16 * ni + lr) * 64 + 32 * ks + 8 * lq), acc[h][ni]);
            }
        }
        __syncthreads();
#pragma unroll
        for (int h = 0; h < 4; ++h)
#pragma unroll
            for (int ni = 0; ni < 4; ++ni) { float ss = acc[h][ni][0] * acc[h][ni][0] + acc[h][ni][1] * acc[h][ni][1] + acc[h][ni][2] * acc[h][ni][2] + acc[h][ni][3] * acc[h][ni][3];
                ss += __shfl_xor(ss, 16); ss += __shfl_xor(ss, 32);
                if (lq == 0) part[(wave * 4 + h) * 64 + 16 * ni + lr] = ss; }
        __syncthreads();
#pragma unroll
        for (int h = 0; h < 4; ++h) { const int dv0 = 16 * wave + 4 * lq; const f32x4 lg = *(const f32x4*)(a.in[I_GLNG] + dv0);
#pragma unroll
            for (int ni = 0; ni < 4; ++ni) { const int i = 16 * ni + lr; float ss = 0.f;
#pragma unroll
                for (int w = 0; w < 8; ++w) ss += part[(w * 4 + h) * 64 + i];
                const float rstd = rsqrtf(ss * (1.0f / 128.0f) + 1e-6f);
                const size_t m = (size_t)64 * cg + i; const u32x2 gw = *(const u32x2*)(P + m * NIN + 2560 + h * 128 + dv0);
                const float g0 = bflo(gw.x), g1 = bfhi(gw.x), g2 = bflo(gw.y), g3 = bfhi(gw.y);
                u32x2 w; w.x = pk2(acc[h][ni][0] * rstd * lg.x * (g0 * sigmoidf_(g0)), acc[h][ni][1] * rstd * lg.y * (g1 * sigmoidf_(g1)));
                w.y = pk2(acc[h][ni][2] * rstd * lg.z * (g2 * sigmoidf_(g2)), acc[h][ni][3] * rstd * lg.w * (g3 * sigmoidf_(g3)));
                *(u32x2*)(ACT + m * D + 512 + h * 128 + dv0) = w; }
        }
    }
}

constexpr int NPH = 25;
__global__ void __launch_bounds__(NTHREADS) fwd_megakernel(Args a_) {
    extern __shared__ __attribute__((aligned(16))) unsigned char lds_raw[];
    LAS unsigned char* lds = (LAS unsigned char*)lds_raw;
    const int tid = threadIdx.x, lane = tid & 63, wave = __builtin_amdgcn_readfirstlane(tid >> 6);
    const int G = gridDim.x, bid = blockIdx.x;
#if MK_XCDBAR
    volatile LAS unsigned* MISC = (volatile LAS unsigned*)(lds + MISC_OFF);
    if (tid < 64) MISC[tid] = 0u;
    __syncthreads();
    XcdBarrier xbar = xcd_barrier_post((unsigned*)(a_.ws + WS_CTL) + 1024, MISC + 8);
#define GRID_BAR() xcd_barrier(xbar)
#else
    cg::grid_group grid = cg::this_grid();
#define GRID_BAR() grid.sync()
#endif
    const int lo = a_.ph_lo, hi = a_.ph_hi;
#ifdef ONLY_PH
#define IN(k) ((k) == ONLY_PH && lo <= (k) && (k) < hi)
#else
#define IN(k) (lo <= (k) && (k) < hi)
#endif
#define SEAM(k) do { if (IN(k) && IN((k) + 1)) GRID_BAR(); } while (0)
    CArgs* const kp = (CArgs*)__builtin_amdgcn_kernarg_segment_ptr();
#define PHASE(k, ...) do { if (IN(k)) { CArgs* ap_ = kp; asm volatile("" : "+s"(ap_)); CArgs& a = *ap_; \
        __VA_ARGS__ } } while (0)
#define WS(off) (a.ws + (off))
    pg8::StaticOrder S;

    PHASE(0, ph_prologue(a, lds, tid, wave, lane););
    SEAM(0);
    PHASE(1, ph_norm1_l0(a, wave, lane););
    SEAM(1);
    PHASE(2, pg8::Gemm g{(const bf16*)WS(WS_ACT), (const bf16*)WS(WS_WIN0), D, D, D, 1 << 30, 0, nullptr, -1}; S.init(MT / 256, NIN / 256, G, bid);
        pg8::EpiBf16<1> E{(bf16*)WS(WS_P), NIN, nullptr}; pg8::gemm_phase(lds, g, S, E););
    SEAM(2);
    PHASE(3, pg8::Gemm g{(const bf16*)WS(WS_P) + 3072, (const bf16*)WS(WS_WB2T) + (size_t)2048 * 256, NIN, 256, 256, 1 << 30, 0, nullptr, -1}; S.init(MT / 256, 2, G, bid);
        pg8::EpiBf16<0> E{(bf16*)WS(WS_Q2), 512, nullptr}; pg8::gemm_phase(lds, g, S, E););
    if (IN(3) && IN(4)) __syncthreads();
    PHASE(4, ph_rwkv_prep(a, lds, tid, wave, lane););
    SEAM(4);
    PHASE(5, ph_rwkv_seq(a, lds, tid, wave, lane););
    SEAM(5);
    PHASE(6, ph_rwkv_readout(a, wave, lane););
    SEAM(6);
    PHASE(7, pg8::Gemm g{(const bf16*)WS(WS_ACT), (const bf16*)WS(WS_WOUT0), D, D, D, 1 << 30, 0, nullptr, -1}; S.init(MT / 256, D / 256, G, bid);
        pg8::EpiResid E{a.in[I_X], a.in[I_CTX], a.out, (float*)WS(WS_XC), (const float*)WS(WS_MOD) + 2048}; pg8::gemm_phase(lds, g, S, E););
    SEAM(7);
    PHASE(8, ph_norm2_router(a, 0, MT, lds, tid, wave, lane););
    SEAM(8);
    PHASE(9, ph_topk(a, 0, lds, tid, wave, lane););
    SEAM(9);
    PHASE(11, pg8::Gemm g{(const bf16*)WS(WS_ACT), (const bf16*)WS(WS_W13T), D, D, D, RPE0 / 256, (size_t)3072 * D, (const int*)WS(WS_IDX), 16}; S.init(NE * RPE0 / 256, 3072 / 256, G, bid);
        pg8::EpiSwiglu E{(bf16*)WS(WS_P), DE}; pg8::gemm_phase<pg8::EpiSwiglu, true>(lds, g, S, E););
    SEAM(11);
    PHASE(12, pg8::Gemm g{(const bf16*)WS(WS_P), (const bf16*)WS(WS_W2T), DE, DE, DE, RPE0 / 256, (size_t)D * DE, nullptr, 16}; S.init(NE * RPE0 / 256, D / 256, G, bid);
        pg8::EpiBf16<0> E{(bf16*)WS(WS_Q2), D, nullptr}; pg8::gemm_phase(lds, g, S, E););
    SEAM(12);
    PHASE(13, ph_combine<true>(a, 0, MT, wave, lane););
    SEAM(13);
    PHASE(14, pg8::Gemm g{(const bf16*)WS(WS_ACT), (const bf16*)WS(WS_WIN1), D, D, D, 1 << 30, 0, nullptr, -1}; S.init(MT / 256, NIN / 256, G, bid);
        pg8::EpiBf16<0> E{(bf16*)WS(WS_P), NIN, nullptr}; pg8::gemm_phase(lds, g, S, E););
    SEAM(14);
    PHASE(15, ph_l1_prep(a, lds, tid, wave, lane););
    SEAM(15);
    PHASE(16, ph_nat_gla(a, lds, tid, wave, lane););
    SEAM(16);
    PHASE(17, ph_gla_readout(a, lds, tid, wave, lane););
    SEAM(17);
    PHASE(18, pg8::Gemm g{(const bf16*)WS(WS_ACT), (const bf16*)WS(WS_WOUT1), D, D, D, 1 << 30, 0, nullptr, -1}; S.init(ML / 256, D / 256, G, bid);
        pg8::EpiResid E{a.out, (const float*)WS(WS_XC), a.out, (float*)WS(WS_XC), (const float*)WS(WS_MOD) + 5 * 6144 + 2048}; pg8::gemm_phase(lds, g, S, E););
    SEAM(18);
    PHASE(19, ph_norm2_router(a, 1, ML, lds, tid, wave, lane););
    SEAM(19);
    PHASE(20, ph_topk(a, 1, lds, tid, wave, lane););
    SEAM(20);
    PHASE(22, pg8::Gemm g{(const bf16*)WS(WS_ACT), (const bf16*)WS(WS_W13T), D, D, D, RPE1 / 256, (size_t)3072 * D, (const int*)WS(WS_IDX), -1}; S.init(NE * RPE1 / 256, 3072 / 256, G, bid);
        pg8::EpiSwiglu E{(bf16*)WS(WS_P), DE}; pg8::gemm_phase<pg8::EpiSwiglu, true>(lds, g, S, E););
    SEAM(22);
    PHASE(23, pg8::Gemm g{(const bf16*)WS(WS_P), (const bf16*)WS(WS_W2T), DE, DE, DE, RPE1 / 256, (size_t)D * DE, nullptr, -1}; S.init(NE * RPE1 / 256, D / 256, G, bid);
        pg8::EpiBf16<0> E{(bf16*)WS(WS_Q2), D, nullptr}; pg8::gemm_phase(lds, g, S, E););
    SEAM(23);
    PHASE(24, ph_combine<false>(a, 1, ML, wave, lane););
#undef PHASE
#undef WS
#undef IN
#undef SEAM
}

extern "C" void kernel_launch(void* const* d_in, const int* in_sizes, int n_in, void* d_out, int out_size, void* d_ws, size_t ws_size, hipStream_t stream) {
    static int grid = 0;
    if (grid == 0) {
        if (n_in != 33 || out_size != ML * D || ws_size < WS_NEED) { fprintf(stderr, "kernel_launch: unexpected problem (n_in %d, out %d, ws %zu < %zu); nothing launched\n", n_in, out_size, ws_size, (size_t)WS_END); grid = -1; return; }
        int dev = 0, cus = 0, per_cu = 0;
        if (hipGetDevice(&dev) != hipSuccess || hipDeviceGetAttribute(&cus, hipDeviceAttributeMultiprocessorCount, dev) != hipSuccess) { grid = -1; return; }
        if (hipFuncSetAttribute((const void*)fwd_megakernel, hipFuncAttributeMaxDynamicSharedMemorySize, LDS_BYTES) != hipSuccess) { fprintf(stderr, "kernel_launch: hipFuncSetAttribute failed\n"); grid = -1; return; }
        if (hipOccupancyMaxActiveBlocksPerMultiprocessor(&per_cu, (const void*)fwd_megakernel, NTHREADS, LDS_BYTES) != hipSuccess || per_cu < 1) { fprintf(stderr, "kernel_launch: occupancy query says %d blocks per CU\n", per_cu); per_cu = 1; }
        (void)hipGetLastError();
        grid = cus;
    }
    if (grid < 0) return;
    (void)hipMemsetAsync((char*)d_ws + WS_CTL, 0, CTL_ZERO_BYTES, stream);
    Args a{};
    for (int i = 0; i < 33; ++i) a.in[i] = (const float*)d_in[i];
    a.out = (float*)d_out; a.ws = (unsigned char*)d_ws;
#if MK_MULTI
    for (int ph = 0; ph < NPH; ++ph) { a.ph_lo = ph; a.ph_hi = ph + 1; const int reps = ((MK_REPEAT_MASK >> ph) & 1) ? 2 : 1;
        for (int r = 0; r < reps; ++r) hipLaunchKernelGGL(fwd_megakernel, dim3(grid), dim3(NTHREADS), LDS_BYTES, stream, a); }
#else
    a.ph_lo = 0; a.ph_hi = NPH;
    void* args[] = {&a};
    hipError_t e = hipLaunchCooperativeKernel((const void*)fwd_megakernel, dim3(grid), dim3(NTHREADS), args, LDS_BYTES, stream);
    if (e != hipSuccess) fprintf(stderr, "kernel_launch: cooperative launch failed: %s (grid %d)\n", hipGetErrorString(e), grid);
#endif
}
```

```cpp
#include <hip/hip_runtime.h>
#include <hip/hip_cooperative_groups.h>
#include <cstdio>
#include <cstdint>
namespace cg = cooperative_groups;

#ifndef MK_MULTI
#define MK_MULTI 0
#endif
#ifndef MK_REPEAT_MASK
#define MK_REPEAT_MASK 0u
#endif
#ifndef DBG_REP
#define DBG_REP 0
#endif
#define REPS(k) ((DBG_REP == (k)) ? 2 : 1)
#ifndef MK_SP2
#define MK_SP2 1
#endif
#ifndef MK_XCDBAR
#define MK_XCDBAR 1
#endif

#define LAS __attribute__((address_space(3)))
#define GAS __attribute__((address_space(1)))
typedef unsigned short bf16;
typedef short bf16x8 __attribute__((ext_vector_type(8)));
typedef float f32x4 __attribute__((ext_vector_type(4)));
typedef float f32x2 __attribute__((ext_vector_type(2)));
typedef float f32x16 __attribute__((ext_vector_type(16)));
typedef unsigned u32x4 __attribute__((ext_vector_type(4)));
typedef unsigned u32x2 __attribute__((ext_vector_type(2)));

constexpr int D = 1024, NB = 4, SEQ = 8192, CTXL = 256;
constexpr int ML = NB * SEQ;
constexpr int MC = NB * CTXL;
constexpr int MT = ML + MC;
constexpr int NIN = 3328;
constexpr int ODD_IN = 3088;
constexpr int LDP0 = 2816;
constexpr int NQ2 = 2560;
constexpr int NE = 16, DE = 1536;
constexpr int RPE0 = 4352, RPE1 = 4096;
constexpr int NTHREADS = 512, NWAVES = 8;

constexpr size_t MiB = 1u << 20;
constexpr size_t WS_CTL = 0, CTL_ZERO_BYTES = 64 * 1024;
constexpr size_t WS_MOD = 1 * MiB;
constexpr size_t WS_BIAS2 = WS_MOD + 256 * 1024;
constexpr size_t WS_ROPE = WS_BIAS2 + 16 * 1024;
constexpr size_t WS_WB2T = 2 * MiB;
constexpr size_t WS_WIN0 = 4 * MiB, WS_WIN1 = 11 * MiB;
constexpr size_t WS_WOUT0 = 18 * MiB, WS_WOUT1 = 20 * MiB;
constexpr size_t WS_XC = 22 * MiB;
constexpr size_t WS_AFF = 26 * MiB;
constexpr size_t WS_INV = 29 * MiB;
constexpr size_t WS_IDX = 32 * MiB;
constexpr size_t WS_W13T = 33 * MiB;
constexpr size_t WS_W2T = 129 * MiB;
constexpr size_t WS_ACT = 177 * MiB;
constexpr size_t WS_Y0 = 243 * MiB, WS_Y1 = 276 * MiB;
constexpr size_t WS_P = 309 * MiB;
constexpr size_t WS_Q2 = 524 * MiB;
constexpr size_t WS_END = 689 * MiB;
constexpr size_t WS_QF = WS_END;
constexpr size_t WS_KF = WS_END + 32 * MiB;
constexpr size_t WS_VF = WS_END + 65 * MiB;
constexpr size_t WS_XPC = WS_END;
constexpr size_t WS_YEC = WS_END + 16 * MiB;
constexpr size_t WS_NEED = WS_END + 98 * MiB;
constexpr size_t WS_GQD = WS_Q2;
constexpr size_t WS_KLOC = WS_Q2 + 32 * MiB;
constexpr size_t WS_GST = WS_Q2 + 98 * MiB;
constexpr size_t WS_GDEC = WS_Q2 + 162 * MiB;

constexpr int RING_BYTES = 131072;
constexpr int MISC_OFF = RING_BYTES;
constexpr int PREP_TAB = RING_BYTES + 1024;
constexpr int LDS_BYTES = RING_BYTES + 1024 + 16384 + 1024;

__device__ __forceinline__ float bflo(unsigned u) { return __uint_as_float(u << 16); }
__device__ __forceinline__ float bfhi(unsigned u) { return __uint_as_float(u & 0xffff0000u); }
__device__ __forceinline__ float bf2f(bf16 h) { return __uint_as_float(((unsigned)h) << 16); }
typedef __bf16 nbf16x2 __attribute__((ext_vector_type(2)));
__device__ __forceinline__ unsigned pk2(float lo, float hi) { const f32x2 f = {lo, hi}; return __builtin_bit_cast(unsigned, __builtin_convertvector(f, nbf16x2)); }
__device__ __forceinline__ unsigned f2bf(float f) { return pk2(f, f) & 0xffffu; }
__device__ __forceinline__ float sigmoidf_(float x) { return __builtin_amdgcn_rcpf(1.0f + __expf(-x)); }
__device__ __forceinline__ float wave_sum(float v) {
#pragma unroll
    for (int o = 1; o < 64; o <<= 1) v += __shfl_xor(v, o);
    return v;
}
template <int CTRL> __device__ __forceinline__ float dpp_f(float v) { return __builtin_bit_cast(float, __builtin_amdgcn_update_dpp(0, __builtin_bit_cast(int, v), CTRL, 0xf, 0xf, false)); }
__device__ __forceinline__ float row16_sum(float v) {
    v += dpp_f<0x128>(v); v += dpp_f<0x124>(v); v += dpp_f<0x122>(v); v += dpp_f<0x121>(v); return v;
}
__device__ __forceinline__ void unpack8(const u32x4 u, float (&f)[8]) { f[0] = bflo(u.x); f[1] = bfhi(u.x); f[2] = bflo(u.y); f[3] = bfhi(u.y); f[4] = bflo(u.z); f[5] = bfhi(u.z); f[6] = bflo(u.w); f[7] = bfhi(u.w); }
__device__ __forceinline__ u32x4 pack8(const float (&f)[8]) { u32x4 w; w.x = pk2(f[0], f[1]); w.y = pk2(f[2], f[3]); w.z = pk2(f[4], f[5]); w.w = pk2(f[6], f[7]); return w; }
__device__ __forceinline__ void load8f(const float* p, float (&f)[8]) { const f32x4 a = *(const f32x4*)p, b = *(const f32x4*)(p + 4); f[0] = a.x; f[1] = a.y; f[2] = a.z; f[3] = a.w; f[4] = b.x; f[5] = b.y; f[6] = b.z; f[7] = b.w; }
#define LDS_BARRIER() do { asm volatile("s_waitcnt lgkmcnt(0)" ::: "memory"); __builtin_amdgcn_s_barrier(); asm volatile("" ::: "memory"); } while (0)
__device__ __forceinline__ int sample_of(int m) { return m < ML ? (m >> 13) : 4; }

namespace pg8 {
constexpr int BM = 256, BK = 64, HALF = 128, HTB = HALF * BK * 2, STAGE_BYTES = 8 * HTB, NXCD = 8, WGM = 8;
__host__ __device__ __forceinline__ int lds_byte(int r, int c) { const int st = (r >> 4) * 2 + (c >> 5), rr = r & 15, cc = c & 31, ob = rr * 64 + cc * 2; return st * 1024 + (ob ^ (((ob >> 9) & 1) << 5)); }
__host__ __device__ __forceinline__ void stage_rc(int b, int& R, int& C) { const int st = b / 1024, sb = b % 1024, swz = sb ^ (((sb >> 9) & 1) << 5); R = (st >> 1) * 16 + swz / 64; C = (st & 1) * 32 + (swz % 64) / 2; }
__host__ __device__ __forceinline__ int perm32(int rho) { const int n = rho >> 4, i = rho & 15; return 8 * (i >> 2) + 4 * n + (i & 3); }

struct Unit { int pm, pn, koff, nt, sub; };
struct Gemm { const bf16* A; const bf16* Bt; int lda, ldb, K, tpg; size_t bgs; const int* gidx; int halftile; };

struct StaticOrder {
    int nM, nN, nwg, G, c, rev;
    __host__ __device__ void init(int nM_, int nN_, int G_, int c_, int rev_ = 0) { nM = nM_; nN = nN_; nwg = nM * nN; G = G_; c = c_; rev = rev_; }
    __host__ __device__ bool next(int i, Unit& u) const { return at((long)i * G + c, u); }
    __host__ __device__ bool at(long L, Unit& u) const {
        if (L >= nwg) return false;
        u.koff = 0; u.nt = 0; u.sub = -1;
        int wgid = rev ? (nwg - 1 - (int)L) : (int)L; { const int q = nwg / NXCD, r = nwg % NXCD, xcd = wgid % NXCD, off = wgid / NXCD; wgid = (xcd < r ? xcd * (q + 1) : r * (q + 1) + (xcd - r) * q) + off; }
        const int nig = WGM * nN, gid = wgid / nig, fm = gid * WGM, gsz = (nM - fm) < WGM ? (nM - fm) : WGM;
        u.pm = fm + ((wgid % nig) % gsz); u.pn = (wgid % nig) / gsz; return true;
    }
};
struct TailOrder {
    StaticOrder M; int ntail, nN, mg, ms, tp0, tps, split, kpiece;
    __host__ __device__ void init(int nMm, int nN_, int G_, int c_, int rev_, int mg_, int ms_, int ntrows, int tp0_, int tps_, int split_, int kpiece_) {
        M.init(nMm, nN_, G_, c_, rev_); nN = nN_; ntail = ntrows * nN_ * split_; mg = mg_; ms = ms_; tp0 = tp0_; tps = tps_; split = split_; kpiece = kpiece_; }
    __host__ __device__ bool next(int i, Unit& u) const {
        const long L = (long)i * M.G + M.c;
        if (L < M.nwg) { M.at(L, u); u.pm = (u.pm / mg) * ms + u.pm % mg; return true; }
        const int j = (int)(L - M.nwg); if (j >= ntail) return false;
        const int t = j / split, sb = j % split;
        u.pm = tp0 + (t / nN) * tps; u.pn = t % nN;
        if (split > 1) { u.sub = sb; u.koff = sb * kpiece; u.nt = kpiece / BK; } else { u.sub = -1; u.koff = 0; u.nt = 0; }
        return true;
    }
};

template <class Epi, bool GATHER = false, class Sched = StaticOrder>
__device__ __forceinline__ void gemm_phase(LAS unsigned char* lds, const Gemm g, const Sched& S, const Epi& E) {
    const int tid = threadIdx.x, wid = __builtin_amdgcn_readfirstlane(tid >> 6), lane = tid & 63, wr = wid >> 2, wc = wid & 3, fr = lane & 15, fq = lane >> 4;
    const int nt_all = g.K / BK;
    unsigned voffB[2]; int rA[2], cA2[2];
#pragma unroll
    for (int i = 0; i < 2; ++i) { int R, C; stage_rc(tid * 16 + i * 8192, R, C); const int Rb = Epi::PERM ? ((R & ~31) + perm32(R & 31)) : R;
        rA[i] = R; cA2[i] = C * 2; voffB[i] = (unsigned)(Rb * g.ldb + C) * 2u; }
    const size_t kstep = (size_t)(BK * 2);
    const size_t hA = (size_t)HALF * g.lda * 2, hB = (size_t)HALF * g.ldb * 2;
    const size_t tA = 2 * hA, tB = 2 * hB;
    const unsigned ldsw = (unsigned)wid * 1024u;
    const int aoff = lds_byte(wr * 64 + fr, fq * 8), boff = lds_byte(wc * 32 + fr, fq * 8);
#define PG8_SA(b, h) (((b) * 2 + (h)) * HTB)
#define PG8_SB(b, h) ((4 + (b) * 2 + (h)) * HTB)
#define PG8_STAGE(bufoff, gbase, voff) do { _Pragma("unroll") for (int _i = 0; _i < 2; ++_i) \
        __builtin_amdgcn_global_load_lds((const unsigned*)((const char*)(gbase) + (voff)[_i]), (LAS unsigned*)(lds + (bufoff) + ldsw + _i * 8192), 16, 0, 0); } while (0)
#define PG8_LDA(dst, b, h) do { _Pragma("unroll") for (int m = 0; m < 4; ++m) _Pragma("unroll") for (int k = 0; k < 2; ++k) dst[m][k] = *(const LAS bf16x8*)(lds + PG8_SA(b, h) + aoff + m * 2048 + k * 1024); } while (0)
#define PG8_LDB(dst, b, h) do { _Pragma("unroll") for (int n = 0; n < 2; ++n) _Pragma("unroll") for (int k = 0; k < 2; ++k) dst[n][k] = *(const LAS bf16x8*)(lds + PG8_SB(b, h) + boff + n * 2048 + k * 1024); } while (0)
#define PG8_MMA(ai, bj, At, Bt) do { __builtin_amdgcn_s_setprio(1); _Pragma("unroll") for (int m = 0; m < 4; ++m) _Pragma("unroll") for (int n = 0; n < 2; ++n) _Pragma("unroll") for (int k = 0; k < 2; ++k) \
        acc[ai][bj][m][n] = __builtin_amdgcn_mfma_f32_16x16x32_bf16(Bt[n][k], At[m][k], acc[ai][bj][m][n], 0, 0, 0); __builtin_amdgcn_s_setprio(0); } while (0)
#define PG8_WAIT_V(n) asm volatile("s_waitcnt vmcnt(" #n ")" ::: "memory")
#define PG8_WAIT_L(n) asm volatile("s_waitcnt lgkmcnt(" #n ")" ::: "memory")
#define PG8_BAR __builtin_amdgcn_s_barrier()
#define PG8_SCHED __builtin_amdgcn_sched_barrier(0)
#define PG8_BPTR(u) ((const char*)g.Bt + ((size_t)((u).pm / g.tpg) * g.bgs) * 2 + (size_t)(u).pn * tB)
#define PG8_AOFF(dstv, u) do { _Pragma("unroll") for (int _h = 0; _h < 2; ++_h) _Pragma("unroll") for (int _i = 0; _i < 2; ++_i) { \
        if (GATHER) dstv[_h][_i] = (unsigned)g.gidx[(u).pm * BM + _h * HALF + rA[_i]] * (unsigned)(g.lda * 2) + (unsigned)cA2[_i]; \
        else dstv[_h][_i] = (unsigned)(rA[_i] * g.lda * 2 + cA2[_i]); } } while (0)
#define PG8_ABASE(u) (GATHER ? (const char*)g.A : (const char*)g.A + (size_t)(u).pm * tA)
    Unit cur, nxt; int ui = 0;
    if (!S.next(0, cur)) return;
    f32x4 acc[2][2][4][2];
#pragma unroll
    for (int a = 0; a < 2; ++a)
#pragma unroll
        for (int b = 0; b < 2; ++b)
#pragma unroll
            for (int m = 0; m < 4; ++m)
#pragma unroll
                for (int n = 0; n < 2; ++n) acc[a][b][m][n] = (f32x4){0.f, 0.f, 0.f, 0.f};
    bf16x8 At[4][2], B0[2][2], B1[2][2];
    unsigned vA[2][2], vN[2][2];
    PG8_AOFF(vA, cur);
    const char* cA = PG8_ABASE(cur) + cur.koff * 2; const char* cB = PG8_BPTR(cur) + cur.koff * 2;
#if MK_SP2
    PG8_STAGE(PG8_SB(0, 0), cB, voffB); PG8_STAGE(PG8_SB(0, 1), cB + hB, voffB); PG8_STAGE(PG8_SA(0, 0), cA, vA[0]); PG8_STAGE(PG8_SA(0, 1), GATHER ? cA : cA + hA, GATHER ? vA[1] : vA[0]);
    if (wr == 1) PG8_BAR;
    PG8_WAIT_V(2); PG8_BAR;
    PG8_STAGE(PG8_SB(1, 0), cB + kstep, voffB); PG8_STAGE(PG8_SA(1, 0), cA + kstep, vA[0]); PG8_STAGE(PG8_SB(1, 1), cB + hB + kstep, voffB);
    PG8_WAIT_V(6); PG8_BAR;
#else
    PG8_STAGE(PG8_SB(0, 0), cB, voffB); PG8_STAGE(PG8_SA(0, 0), cA, vA[0]); PG8_STAGE(PG8_SB(0, 1), cB + hB, voffB); PG8_STAGE(PG8_SA(0, 1), GATHER ? cA : cA + hA, GATHER ? vA[1] : vA[0]);
    if (wr == 1) PG8_BAR;
    PG8_WAIT_V(4); PG8_BAR;
    PG8_STAGE(PG8_SB(1, 0), cB + kstep, voffB); PG8_STAGE(PG8_SA(1, 0), cA + kstep, vA[0]); PG8_STAGE(PG8_SB(1, 1), cB + hB + kstep, voffB);
    PG8_WAIT_V(6); PG8_BAR;
#endif
    for (;;) {
        const bool has_next = S.next(ui + 1, nxt);
        const char* nA = has_next ? PG8_ABASE(nxt) + nxt.koff * 2 : cA; const char* nB = has_next ? PG8_BPTR(nxt) + nxt.koff * 2 : cB;
        const int nt = cur.nt ? cur.nt : nt_all;
        if (GATHER) {
            if (has_next) { PG8_AOFF(vN, nxt); }
            else {
#pragma unroll
                for (int _h = 0; _h < 2; ++_h)
#pragma unroll
                    for (int _i = 0; _i < 2; ++_i) vN[_h][_i] = vA[_h][_i]; }
        }
        const bool skip1 = g.halftile >= 0 && (cur.pm % g.tpg) == g.halftile;
#pragma unroll 1
        for (int t = 0; t < nt; t += 2) {
            const bool last = (t == nt - 2);
            const char* a1 = cA + (size_t)(t + 1) * kstep;
            const char* a2 = last ? nA : cA + (size_t)(t + 2) * kstep; const char* b2 = last ? nB : cB + (size_t)(t + 2) * kstep;
            const char* a3 = a2 + kstep; const char* b3 = b2 + kstep;
            unsigned v2[2][2];
#pragma unroll
            for (int _h = 0; _h < 2; ++_h)
#pragma unroll
                for (int _i = 0; _i < 2; ++_i) v2[_h][_i] = (GATHER && last) ? vN[_h][_i] : vA[_h][_i];
#if MK_SP2
            PG8_LDB(B0, 0, 0); PG8_LDB(B1, 0, 1); PG8_SCHED; PG8_LDA(At, 0, 0); PG8_STAGE(PG8_SA(1, 1), GATHER ? a1 : a1 + hA, GATHER ? vA[1] : vA[0]);
            PG8_WAIT_V(8); PG8_WAIT_L(0); PG8_BAR; PG8_MMA(0, 0, At, B0); PG8_MMA(0, 1, At, B1); PG8_BAR; PG8_SCHED;
            PG8_LDA(At, 0, 1); PG8_STAGE(PG8_SB(0, 0), b2, voffB); PG8_STAGE(PG8_SB(0, 1), b2 + hB, voffB); PG8_STAGE(PG8_SA(0, 0), a2, v2[0]);
            PG8_WAIT_V(8); PG8_WAIT_L(0); PG8_BAR; if (!skip1) { PG8_MMA(1, 0, At, B0); PG8_MMA(1, 1, At, B1); } PG8_BAR; PG8_SCHED;
            PG8_LDB(B0, 1, 0); PG8_LDB(B1, 1, 1); PG8_SCHED; PG8_LDA(At, 1, 0); PG8_STAGE(PG8_SA(0, 1), GATHER ? a2 : a2 + hA, GATHER ? v2[1] : v2[0]);
            PG8_WAIT_V(8); PG8_WAIT_L(0); PG8_BAR; PG8_MMA(0, 0, At, B0); PG8_MMA(0, 1, At, B1); PG8_BAR; PG8_SCHED;
            PG8_LDA(At, 1, 1); PG8_STAGE(PG8_SB(1, 0), b3, voffB); PG8_STAGE(PG8_SB(1, 1), b3 + hB, voffB); PG8_STAGE(PG8_SA(1, 0), a3, v2[0]);
            PG8_WAIT_V(8); PG8_WAIT_L(0); PG8_BAR; if (!skip1) { PG8_MMA(1, 0, At, B0); PG8_MMA(1, 1, At, B1); } PG8_BAR; PG8_SCHED;
#else
            PG8_LDB(B0, 0, 0); PG8_SCHED; PG8_LDA(At, 0, 0); PG8_STAGE(PG8_SA(1, 1), GATHER ? a1 : a1 + hA, GATHER ? vA[1] : vA[0]);
            PG8_WAIT_L(8); PG8_BAR; PG8_WAIT_L(0); PG8_MMA(0, 0, At, B0); PG8_BAR; PG8_SCHED;
            PG8_LDB(B1, 0, 1); PG8_STAGE(PG8_SB(0, 0), b2, voffB);
            PG8_BAR; PG8_WAIT_L(0); PG8_MMA(0, 1, At, B1); PG8_BAR;
            PG8_LDA(At, 0, 1); PG8_STAGE(PG8_SA(0, 0), a2, v2[0]);
            PG8_BAR; PG8_WAIT_L(0); if (!skip1) PG8_MMA(1, 0, At, B0); PG8_BAR; PG8_SCHED;
            PG8_STAGE(PG8_SB(0, 1), b2 + hB, voffB);
            PG8_WAIT_V(6); PG8_BAR; if (!skip1) PG8_MMA(1, 1, At, B1); PG8_BAR;
            PG8_LDB(B0, 1, 0); PG8_SCHED; PG8_LDA(At, 1, 0); PG8_STAGE(PG8_SA(0, 1), GATHER ? a2 : a2 + hA, GATHER ? v2[1] : v2[0]);
            PG8_WAIT_L(8); PG8_BAR; PG8_WAIT_L(0); PG8_MMA(0, 0, At, B0); PG8_BAR; PG8_SCHED;
            PG8_LDB(B1, 1, 1); PG8_STAGE(PG8_SB(1, 0), b3, voffB);
            PG8_BAR; PG8_WAIT_L(0); PG8_MMA(0, 1, At, B1); PG8_BAR;
            PG8_LDA(At, 1, 1); PG8_STAGE(PG8_SA(1, 0), a3, v2[0]);
            PG8_BAR; PG8_WAIT_L(0); if (!skip1) PG8_MMA(1, 0, At, B0); PG8_BAR; PG8_SCHED;
            PG8_STAGE(PG8_SB(1, 1), b3 + hB, voffB);
            PG8_WAIT_V(6); PG8_BAR; if (!skip1) PG8_MMA(1, 1, At, B1); PG8_BAR;
#endif
        }
        if (wr == 0) PG8_BAR;
        { int fr_ = fr, fq_ = fq; asm volatile("" : "+v"(fr_), "+v"(fq_));
          E(acc, cur, wr, wc, fr_, fq_); }
        if (!has_next) break;
#pragma unroll
        for (int a = 0; a < 2; ++a)
#pragma unroll
            for (int b = 0; b < 2; ++b)
#pragma unroll
                for (int m = 0; m < 4; ++m)
#pragma unroll
                    for (int n = 0; n < 2; ++n) acc[a][b][m][n] = (f32x4){0.f, 0.f, 0.f, 0.f};
        cur = nxt; cA = nA; cB = nB; ++ui;
        if (wr == 1) PG8_BAR;
        if (GATHER) {
#pragma unroll
            for (int _h = 0; _h < 2; ++_h)
#pragma unroll
                for (int _i = 0; _i < 2; ++_i) vA[_h][_i] = vN[_h][_i]; }
    }
    PG8_WAIT_V(0);
    PG8_BAR;
#undef PG8_SA
#undef PG8_SB
#undef PG8_STAGE
#undef PG8_LDA
#undef PG8_LDB
#undef PG8_MMA
#undef PG8_WAIT_V
#undef PG8_WAIT_L
#undef PG8_BAR
#undef PG8_SCHED
#undef PG8_BPTR
#undef PG8_AOFF
#undef PG8_ABASE
}

template <int MODE> struct EpiBf16 {
    static constexpr bool PERM = true;
    bf16* O; int ldc; const float* bias;
    __device__ __forceinline__ void operator()(const f32x4 (&acc)[2][2][4][2], const Unit& u, int wr, int wc, int fr, int fq) const {
        const int row0 = u.pm * BM + wr * 64 + fr; const int col0 = u.pn * BM + wc * 32 + 8 * fq;
#pragma unroll
        for (int bj = 0; bj < 2; ++bj) {
            f32x4 b0 = (f32x4){0.f, 0.f, 0.f, 0.f}, b1 = b0;
            if (MODE == 2) { b0 = *(const f32x4*)(bias + col0 + bj * HALF); b1 = *(const f32x4*)(bias + col0 + bj * HALF + 4); }
            int act = 0;
            if (MODE == 1) { if (u.pn == 12) act = (bj == 1) ? 2 : (wc < 2 ? 1 : 0); }
            if (MODE == 2) { act = u.pn < 4 ? 3 : (u.pn < 8 ? 2 : 0); }
#pragma unroll
            for (int ai = 0; ai < 2; ++ai)
#pragma unroll
                for (int m = 0; m < 4; ++m) {
                    f32x4 v0 = acc[ai][bj][m][0] + b0, v1 = acc[ai][bj][m][1] + b1;
                    if (MODE != 0) {
                        if (act == 1) {
#pragma unroll
                            for (int j = 0; j < 4; ++j) { v0[j] = tanhf(v0[j]); v1[j] = tanhf(v1[j]); }
                        } else if (act == 2) {
#pragma unroll
                            for (int j = 0; j < 4; ++j) { v0[j] = sigmoidf_(v0[j]); v1[j] = sigmoidf_(v1[j]); }
                        } else if (act == 3) {
#pragma unroll
                            for (int j = 0; j < 4; ++j) { v0[j] = -0.6065306597f * sigmoidf_(v0[j]); v1[j] = -0.6065306597f * sigmoidf_(v1[j]); }
                        }
                    }
                    u32x4 w; w.x = pk2(v0[0], v0[1]); w.y = pk2(v0[2], v0[3]); w.z = pk2(v1[0], v1[1]); w.w = pk2(v1[2], v1[3]);
                    *(u32x4*)(O + (size_t)(row0 + ai * HALF + m * 16) * ldc + col0 + bj * HALF) = w;
                }
        }
    }
};
struct EpiInproj0 {
    static constexpr bool PERM = true;
    bf16* O; int ldc;
    __device__ __forceinline__ void operator()(const f32x4 (&acc)[2][2][4][2], const Unit& u, int wr, int wc, int fr, int fq) const {
        const int row0 = u.pm * BM + wr * 64 + fr;
        if (u.pn < 4) {
            const int col0 = u.pn * HALF + wc * 32 + 8 * fq;
#pragma unroll
            for (int ai = 0; ai < 2; ++ai)
#pragma unroll
                for (int m = 0; m < 4; ++m) { const f32x4 v0 = acc[ai][0][m][0] * acc[ai][1][m][0], v1 = acc[ai][0][m][1] * acc[ai][1][m][1];
                    u32x4 w; w.x = pk2(v0[0], v0[1]); w.y = pk2(v0[2], v0[3]); w.z = pk2(v1[0], v1[1]); w.w = pk2(v1[2], v1[3]);
                    *(u32x4*)(O + (size_t)(row0 + ai * HALF + m * 16) * ldc + col0) = w; }
        } else {
            const int col0 = u.pn * BM - 512 + wc * 32 + 8 * fq;
#pragma unroll
            for (int bj = 0; bj < 2; ++bj) {
                const int act = u.pn == 12 ? ((bj == 1) ? 2 : (wc < 2 ? 1 : 0)) : 0;
#pragma unroll
                for (int ai = 0; ai < 2; ++ai)
#pragma unroll
                    for (int m = 0; m < 4; ++m) { f32x4 v0 = acc[ai][bj][m][0], v1 = acc[ai][bj][m][1];
                        if (act == 1) {
#pragma unroll
                            for (int j = 0; j < 4; ++j) { v0[j] = tanhf(v0[j]); v1[j] = tanhf(v1[j]); }
                        } else if (act == 2) {
#pragma unroll
                            for (int j = 0; j < 4; ++j) { v0[j] = sigmoidf_(v0[j]); v1[j] = sigmoidf_(v1[j]); }
                        }
                        u32x4 w; w.x = pk2(v0[0], v0[1]); w.y = pk2(v0[2], v0[3]); w.z = pk2(v1[0], v1[1]); w.w = pk2(v1[2], v1[3]);
                        *(u32x4*)(O + (size_t)(row0 + ai * HALF + m * 16) * ldc + col0 + bj * HALF) = w; }
            }
        }
    }
};
struct EpiSwiglu {
    static constexpr bool PERM = true;
    bf16* O; int ldc;
    __device__ __forceinline__ void operator()(const f32x4 (&acc)[2][2][4][2], const Unit& u, int wr, int wc, int fr, int fq) const {
        const int row0 = u.pm * BM + wr * 64 + fr; const int col0 = u.pn * HALF + wc * 32 + 8 * fq;
#pragma unroll
        for (int ai = 0; ai < 2; ++ai)
#pragma unroll
            for (int m = 0; m < 4; ++m) {
                f32x4 v0, v1;
#pragma unroll
                for (int j = 0; j < 4; ++j) { const float a0 = acc[ai][0][m][0][j], a1 = acc[ai][0][m][1][j]; v0[j] = a0 * sigmoidf_(a0) * acc[ai][1][m][0][j]; v1[j] = a1 * sigmoidf_(a1) * acc[ai][1][m][1][j]; }
                u32x4 w; w.x = pk2(v0[0], v0[1]); w.y = pk2(v0[2], v0[3]); w.z = pk2(v1[0], v1[1]); w.w = pk2(v1[2], v1[3]);
                *(u32x4*)(O + (size_t)(row0 + ai * HALF + m * 16) * ldc + col0) = w;
            }
    }
};
template <bool INBF> struct EpiResid {
    static constexpr bool PERM = true;
    const void* xl; bf16* ol; const float* gate; float* part;
    __device__ __forceinline__ void operator()(const f32x4 (&acc)[2][2][4][2], const Unit& u, int wr, int wc, int fr, int fq) const {
        const bool isctx = u.pm >= (ML / BM);
        const int rbase = (isctx ? (u.pm - ML / BM) : u.pm) * BM + wr * 64 + fr; const int col0 = u.pn * BM + wc * 32 + 8 * fq;
        if (u.sub >= 0) {
            float* pp = part + (size_t)u.sub * MC * D;
#pragma unroll
            for (int ai = 0; ai < 2; ++ai)
#pragma unroll
                for (int m = 0; m < 4; ++m) { const size_t off = (size_t)(rbase + ai * HALF + m * 16) * D + col0;
#pragma unroll
                    for (int bj = 0; bj < 2; ++bj)
#pragma unroll
                        for (int n = 0; n < 2; ++n) *(f32x4*)(pp + off + bj * HALF + 4 * n) = acc[ai][bj][m][n]; }
            return;
        }
        const int smp = u.pm >> 5;
        f32x4 gv[2][2];
#pragma unroll
        for (int bj = 0; bj < 2; ++bj)
#pragma unroll
            for (int n = 0; n < 2; ++n) gv[bj][n] = *(const f32x4*)(gate + smp * 6144 + col0 + bj * HALF + 4 * n);
#pragma unroll
        for (int ai = 0; ai < 2; ++ai) {
            f32x4 xv[4][2][2];
#pragma unroll
            for (int m = 0; m < 4; ++m) { const size_t row = (size_t)(rbase + ai * HALF + m * 16);
#pragma unroll
                for (int bj = 0; bj < 2; ++bj) {
                    if (INBF) { const u32x4 w = *(const u32x4*)((const bf16*)xl + row * 2048 + col0 + bj * HALF);
                        xv[m][bj][0] = (f32x4){bflo(w.x), bfhi(w.x), bflo(w.y), bfhi(w.y)}; xv[m][bj][1] = (f32x4){bflo(w.z), bfhi(w.z), bflo(w.w), bfhi(w.w)}; }
                    else { const float* xp = (const float*)xl + row * D + col0 + bj * HALF; xv[m][bj][0] = __builtin_nontemporal_load((const f32x4*)xp); xv[m][bj][1] = __builtin_nontemporal_load((const f32x4*)(xp + 4)); } } }
#pragma unroll
            for (int m = 0; m < 4; ++m) { const size_t row = (size_t)(rbase + ai * HALF + m * 16);
#pragma unroll
                for (int bj = 0; bj < 2; ++bj) { const f32x4 v0 = xv[m][bj][0] + gv[bj][0] * acc[ai][bj][m][0], v1 = xv[m][bj][1] + gv[bj][1] * acc[ai][bj][m][1];
                    u32x4 w; w.x = pk2(v0[0], v0[1]); w.y = pk2(v0[2], v0[3]); w.z = pk2(v1[0], v1[1]); w.w = pk2(v1[2], v1[3]);
                    *(u32x4*)(ol + row * 2048 + col0 + bj * HALF) = w; } }
            asm volatile("" ::: "memory"); }
    }
};
struct EpiDown {
    static constexpr bool PERM = true;
    bf16* O; bf16* T;
    __device__ __forceinline__ void operator()(const f32x4 (&acc)[2][2][4][2], const Unit& u, int wr, int wc, int fr, int fq) const {
        const int col0 = u.pn * BM + wc * 32 + 8 * fq;
        bf16* base = u.sub < 0 ? O + (size_t)(u.pm * BM + wr * 64 + fr) * D : T + ((size_t)(u.sub * 16 + u.pm / 17) * HALF + wr * 64 + fr) * D;
        const int nai = u.sub < 0 ? 2 : 1;
#pragma unroll
        for (int bj = 0; bj < 2; ++bj)
#pragma unroll
            for (int ai = 0; ai < 2; ++ai) if (ai < nai) {
#pragma unroll
                for (int m = 0; m < 4; ++m) { const f32x4 v0 = acc[ai][bj][m][0], v1 = acc[ai][bj][m][1];
                    u32x4 w; w.x = pk2(v0[0], v0[1]); w.y = pk2(v0[2], v0[3]); w.z = pk2(v1[0], v1[1]); w.w = pk2(v1[2], v1[3]);
                    *(u32x4*)(base + (size_t)(ai * HALF + m * 16) * D + col0 + bj * HALF) = w; }
            }
    }
};
}

#define XB_TMO      128
#define XB_XCNT(j)  (256  + 64 * (j))
#define XB_XSUB(j)  (1280 + 64 * (j))
#define XB_XGEN(j)  (2304 + 64 * (j))
#define XB_TOP      3328
#define XB_TOPGEN   3392
#define XCD_BAR_WORDS 3456
#define XB_SPIN_CAP (1u << 20)
__device__ __forceinline__ unsigned xb_ld(unsigned* p)              { return __hip_atomic_load(p, __ATOMIC_RELAXED, __HIP_MEMORY_SCOPE_AGENT); }
__device__ __forceinline__ unsigned xb_add(unsigned* p, unsigned v) { return __hip_atomic_fetch_add(p, v, __ATOMIC_RELAXED, __HIP_MEMORY_SCOPE_AGENT); }
__device__ __forceinline__ unsigned xb_xcc_id() { return (unsigned)__builtin_amdgcn_s_getreg((3 << 11) | 20) & 0xFu; }
#define XB_SPIN(cond, bar) do { unsigned _sp = 0; while (cond) { __builtin_amdgcn_s_sleep(1); \
    if ((++_sp & 255u) == 0u) { if (xb_ld(&(bar)[XB_TMO])) break; if (_sp > XB_SPIN_CAP) { atomicAdd(&(bar)[XB_TMO], 1u); break; } } } } while (0)
struct XcdBarrier { unsigned* bar; unsigned x; volatile LAS unsigned* st; };
__device__ __forceinline__ XcdBarrier xcd_barrier_post(unsigned* bar, volatile LAS unsigned* st) {
    XcdBarrier b; b.bar = bar; b.x = xb_xcc_id(); b.st = st;
    if (threadIdx.x == 0) (void)xb_add(&bar[XB_XCNT(b.x)], 1u);
    return b;
}
__device__ __forceinline__ void xcd_barrier_complete(unsigned* bar, unsigned x, unsigned& nloc, unsigned& nx) {
    const unsigned G = gridDim.x * gridDim.y * gridDim.z;
    unsigned sum, cnt, mine, sp = 0u;
    for (;;) {
        sum = 0u; cnt = 0u; mine = 0u;
#pragma unroll
        for (unsigned j = 0; j < 16; ++j) { const unsigned c = xb_ld(&bar[XB_XCNT(j)]); sum += c; cnt += (c > 0u) ? 1u : 0u; mine = (j == x) ? c : mine; }
        if (sum == G) break;
        __builtin_amdgcn_s_sleep(1);
        if ((++sp & 255u) == 0u) { if (xb_ld(&bar[XB_TMO])) break; if (sp > XB_SPIN_CAP) { atomicAdd(&bar[XB_TMO], 1u); break; } }
    }
    nloc = mine > 0u ? mine : 1u; nx = cnt > 0u ? cnt : 1u;
}
__device__ __forceinline__ void xcd_barrier(const XcdBarrier& b) {
    asm volatile("s_waitcnt vmcnt(0)" ::: "memory");
    __syncthreads();
    if (threadIdx.x == 0) {
        unsigned* bar = b.bar;
        __builtin_amdgcn_s_waitcnt(0);
        unsigned nloc = b.st[0], nx = b.st[1];
        if (nloc == 0u) { xcd_barrier_complete(bar, b.x, nloc, nx); b.st[0] = nloc; b.st[1] = nx; }
        const unsigned old = __hip_atomic_fetch_add(&bar[XB_XSUB(b.x)], 1u, __ATOMIC_RELAXED, __HIP_MEMORY_SCOPE_WORKGROUP);
        const unsigned gen = old / nloc;
        if (old + 1u == (gen + 1u) * nloc) {
            __builtin_amdgcn_fence(__ATOMIC_RELEASE, "agent");
            asm volatile("s_waitcnt vmcnt(0)" ::: "memory");
            const unsigned og = xb_add(&bar[XB_TOP], 1u);
            const unsigned tg = og / nx, target = (tg + 1u) * nx;
            if (og + 1u != target) XB_SPIN(xb_ld(&bar[XB_TOP]) < target, bar);
            __builtin_amdgcn_fence(__ATOMIC_ACQUIRE, "agent");
            __hip_atomic_store(&bar[XB_XGEN(b.x)], gen + 1u, __ATOMIC_RELAXED, __HIP_MEMORY_SCOPE_WORKGROUP);
            asm volatile("s_waitcnt vmcnt(0)" ::: "memory");
        } else {
            XB_SPIN(xb_ld(&bar[XB_XGEN(b.x)]) == gen, bar);
            __builtin_amdgcn_fence(__ATOMIC_ACQUIRE, "agent");
            asm volatile("s_waitcnt vmcnt(0)" ::: "memory");
        }
    }
    __syncthreads();
}

struct Args { const float* in[33]; float* out; unsigned char* ws; int ph_lo, ph_hi; };
typedef const Args __attribute__((address_space(4))) CArgs;
enum { I_X = 0, I_C, I_CTX, I_CCTX, I_ADAW, I_ADAB, I_N1G, I_N2G, I_EVWIN, I_EVWOUT, I_CONVW, I_KK, I_KA, I_RK, I_W0, I_WUP, I_A0, I_AUP, I_GUP, I_LNG, I_LNB,
       I_ODWIN, I_ODWOUT, I_QNG, I_KNG, I_RPB, I_GAUP, I_GAB, I_GLNG, I_ROUTER, I_W1, I_W3, I_W2 };

template <int NLD = 64>
__device__ __forceinline__ void transpose_item(const float* W, int K, int N, bf16* WT, int ldt, int item, int maptype, LAS unsigned char* tile, int lane) {
    const int nblk = (N + 63) / 64, kb = item / nblk, nb = item % nblk, k0 = 64 * kb, n0 = 64 * nb;
    int drow0;
    if (maptype == 3) {
        if (n0 < 512) drow0 = (n0 >> 7) * 256 + (n0 & 127);
        else if (n0 < 1024) drow0 = 1024 + (n0 - 512);
        else if (n0 < 1536) drow0 = (((n0 - 1024) >> 7) * 256) + 128 + ((n0 - 1024) & 127);
        else drow0 = n0;
    } else drow0 = maptype == 0 ? n0 : ((n0 >> 7) * 256 + (n0 & 127) + (maptype == 2 ? 128 : 0));
    const int r4 = lane >> 4, c4 = lane & 15;
    const bool nok = (n0 + 4 * c4) < N;
    const float* src = W + (size_t)(k0 + 8 * r4) * N + n0 + (nok ? 4 * c4 : 0);
#define TR_SW(n_) ((((n_) >> 2) ^ (n_)) & 7)
#pragma unroll
    for (int hh = 0; hh < 64 / NLD; ++hh) {
        f32x4 f[NLD / 4];
#pragma unroll
        for (int e = 0; e < NLD / 4; ++e) { const int ee = hh * (NLD / 4) + e; f[e] = __builtin_nontemporal_load((const f32x4*)(src + (size_t)(32 * (ee >> 3) + (ee & 7)) * N)); }
        __builtin_amdgcn_sched_barrier(0);
#pragma unroll
        for (int g = 0; g < NLD / 32; ++g) { const int gg = 4 * (hh * (NLD / 32) + g) + r4;
#pragma unroll
            for (int j = 0; j < 4; ++j) { const int n = 4 * c4 + j;
                u32x4 o0;
                o0.x = pk2(f[8 * g + 0][j], f[8 * g + 1][j]); o0.y = pk2(f[8 * g + 2][j], f[8 * g + 3][j]); o0.z = pk2(f[8 * g + 4][j], f[8 * g + 5][j]); o0.w = pk2(f[8 * g + 6][j], f[8 * g + 7][j]);
                if (!nok) o0 = (u32x4){0u, 0u, 0u, 0u};
                *(LAS u32x4*)(tile + n * 128 + ((gg ^ TR_SW(n)) << 4)) = o0; } }
    }
    asm volatile("s_waitcnt lgkmcnt(0)" ::: "memory");
    const int ch = lane & 7;
#pragma unroll
    for (int it = 0; it < 8; ++it) { const int r = (lane >> 3) + 8 * it;
        const u32x4 v = *(const LAS u32x4*)(tile + r * 128 + ((ch ^ TR_SW(r)) << 4));
        *(u32x4*)(WT + (size_t)(drow0 + r) * ldt + k0 + 8 * ch) = v; }
    asm volatile("s_waitcnt lgkmcnt(0)" ::: "memory");
#undef TR_SW
}
template <int NLD = 64>
__device__ __forceinline__ void moe_convert_item(CArgs& a, int l, int it, LAS unsigned char* tile, int lane) {
    bf16* W13T = (bf16*)(a.ws + WS_W13T); bf16* W2T = (bf16*)(a.ws + WS_W2T);
    const int e = it / 1152, r = it % 1152, which = r / 384, sub = r % 384;
    const size_t wo = ((size_t)l * NE + e) * (size_t)D * DE;
    if (which == 0) transpose_item<NLD>(a.in[I_W1] + wo, D, DE, W13T + (size_t)e * 3072 * D, D, sub, 1, tile, lane);
    else if (which == 1) transpose_item<NLD>(a.in[I_W3] + wo, D, DE, W13T + (size_t)e * 3072 * D, D, sub, 2, tile, lane);
    else transpose_item<NLD>(a.in[I_W2] + wo, DE, D, W2T + (size_t)e * D * DE, DE, sub, 0, tile, lane);
}
__device__ __forceinline__ void moe_convert(CArgs& a, int l, LAS unsigned char* tile, int gw, int NGW, int lane) {
    for (int it = gw; it < 16 * 1152; it += NGW) moe_convert_item(a, l, it, tile, lane);
}

__device__ __forceinline__ void ph_prologue(CArgs& a, LAS unsigned char* lds, int tid, int wave, int lane) {
    const int G = gridDim.x, bid = blockIdx.x;
    float* mod = (float*)(a.ws + WS_MOD);
    LAS float* fl = (LAS float*)lds;
    for (int item = bid; item < 192; item += G) {
        const int l = item / 96, nb = item % 96;
        for (int i = tid; i < 5 * 1024; i += NTHREADS) { const int s = i >> 10, k = i & 1023; const float v = s < 4 ? a.in[I_C][s * 1024 + k] : a.in[I_CCTX][k]; fl[i] = v * __builtin_amdgcn_rcpf(1.0f + __expf(-v)); }
        __syncthreads();
        const int n = nb * 64 + (tid & 63), kg = tid >> 6;
        const float* W = a.in[I_ADAW] + (size_t)l * D * 6144 + n;
        float s0 = 0.f, s1 = 0.f, s2 = 0.f, s3 = 0.f, s4 = 0.f;
#pragma unroll 8
        for (int k = kg * 128; k < kg * 128 + 128; ++k) { const float w = W[(size_t)k * 6144]; s0 += fl[k] * w; s1 += fl[1024 + k] * w; s2 += fl[2048 + k] * w; s3 += fl[3072 + k] * w; s4 += fl[4096 + k] * w; }
        LAS float* red = fl + 5120;
        red[(kg * 5 + 0) * 64 + (tid & 63)] = s0; red[(kg * 5 + 1) * 64 + (tid & 63)] = s1; red[(kg * 5 + 2) * 64 + (tid & 63)] = s2; red[(kg * 5 + 3) * 64 + (tid & 63)] = s3; red[(kg * 5 + 4) * 64 + (tid & 63)] = s4;
        __syncthreads();
        if (tid < 320) { const int s = tid >> 6, nn = tid & 63; float t = 0.f;
#pragma unroll
            for (int q = 0; q < 8; ++q) t += red[(q * 5 + s) * 64 + nn];
            mod[(l * 5 + s) * 6144 + nb * 64 + nn] = t + a.in[I_ADAB][l * 6144 + nb * 64 + nn]; }
        __syncthreads();
    }
    {
        bf16* WB2T = (bf16*)(a.ws + WS_WB2T); float* bias2 = (float*)(a.ws + WS_BIAS2); float* rope = (float*)(a.ws + WS_ROPE); bf16* WIN1 = (bf16*)(a.ws + WS_WIN1);
        const int gt = bid * NTHREADS + tid, GT = G * NTHREADS;
        for (int i = gt; i < NQ2 * 256; i += GT) {
            const int n = i >> 8, k = i & 255; float v = 0.f;
            if (n < 1024) { if (k < 64) v = a.in[I_WUP][((n >> 9) * 64 + k) * 512 + (n & 511)]; }
            else if (n < 2048) { if (k >= 64 && k < 128) v = a.in[I_AUP][(((n - 1024) >> 9) * 64 + (k - 64)) * 512 + (n & 511)]; }
            else { if (k >= 128) v = a.in[I_GUP][(k - 128) * 512 + (n - 2048)]; }
            WB2T[i] = (bf16)f2bf(v);
        }
        for (int i = gt; i < NQ2; i += GT) bias2[i] = i < 1024 ? a.in[I_W0][i] : (i < 2048 ? a.in[I_A0][i - 1024] : 0.f);
        for (int i = gt; i < 128 * 16; i += GT) { const int pos = i >> 4, f = i & 15; const float inv = powf(10000.0f, -(float)f / 16.0f); const float ang = (float)pos * inv; float sn, cs; sincosf(ang, &sn, &cs); rope[2 * i] = cs; rope[2 * i + 1] = sn; }
        for (int i = gt; i < (NIN - 3136) * D / 8; i += GT) *(u32x4*)(WIN1 + (size_t)3136 * D + (size_t)i * 8) = (u32x4){0u, 0u, 0u, 0u};
    }
    {
        const int gw = bid * NWAVES + wave, NGW = G * NWAVES;
        __syncthreads();
        for (int it = gw; it < 2128; it += NGW) {
            int r = it;
            if (r < 832) { transpose_item(a.in[I_EVWIN], D, NIN, (bf16*)(a.ws + WS_WIN0), D, r, 3, lds + wave * 8192, lane); continue; } r -= 832;
            if (r < 256) { transpose_item(a.in[I_EVWOUT], D, D, (bf16*)(a.ws + WS_WOUT0), D, r, 0, lds + wave * 8192, lane); continue; } r -= 256;
            if (r < 784) { transpose_item(a.in[I_ODWIN], D, ODD_IN, (bf16*)(a.ws + WS_WIN1), D, r, 0, lds + wave * 8192, lane); continue; } r -= 784;
            transpose_item(a.in[I_ODWOUT], D, D, (bf16*)(a.ws + WS_WOUT1), D, r, 0, lds + wave * 8192, lane);
        }
    }
}

__device__ __forceinline__ void norm_mod_store(const f32x4 (&v)[4], float rstd, const float* g, const float* sc, const float* sh, bf16* orow, int lane, f32x4 (&hout)[4]) {
    unsigned long long* o8 = (unsigned long long*)orow + lane;
#pragma unroll
    for (int j = 0; j < 4; ++j) {
        const f32x4 gg = *((const f32x4*)g + lane + 64 * j), s1 = *((const f32x4*)sc + lane + 64 * j), s0 = *((const f32x4*)sh + lane + 64 * j);
        f32x4 h = v[j] * rstd * gg * (s1 + 1.0f) + s0; hout[j] = h;
        o8[64 * j] = (unsigned long long)pk2(h.x, h.y) | ((unsigned long long)pk2(h.z, h.w) << 32);
    }
}
struct ModP { f32x4 a[4], b[4]; };
__device__ __forceinline__ void modp_load(ModP& p, const float* g, const float* sc, const float* sh, int lane) {
#pragma unroll
    for (int j = 0; j < 4; ++j) { const f32x4 gg = *((const f32x4*)g + lane + 64 * j), s1 = *((const f32x4*)sc + lane + 64 * j), s0 = *((const f32x4*)sh + lane + 64 * j); p.a[j] = gg * (s1 + 1.0f); p.b[j] = s0; }
}
__device__ __forceinline__ void norm_mod_store_p(const f32x4 (&v)[4], float rstd, const ModP& p, bf16* orow, int lane, f32x4 (&hout)[4]) {
    unsigned long long* o8 = (unsigned long long*)orow + lane;
#pragma unroll
    for (int j = 0; j < 4; ++j) { f32x4 h = v[j] * rstd * p.a[j] + p.b[j]; hout[j] = h; o8[64 * j] = (unsigned long long)pk2(h.x, h.y) | ((unsigned long long)pk2(h.z, h.w) << 32); }
}
struct SampleSplit { int smp, wi, wps, nlat, nctx; };
__device__ __forceinline__ SampleSplit sample_split(int gw, int NGW, int per_sample, int nctx_items) {
    SampleSplit q; q.wps = NGW >> 2; q.smp = gw / q.wps; q.wi = gw % q.wps; q.nlat = q.wi < per_sample ? (per_sample - q.wi + q.wps - 1) / q.wps : 0; q.nctx = gw < nctx_items ? (nctx_items - gw + NGW - 1) / NGW : 0; return q;
}
__device__ __forceinline__ void xrow_load(const float* out, int m, int lane, f32x4 (&v)[4]) {
    const u32x2* xb = (const u32x2*)((const bf16*)out + (size_t)m * 2048) + lane;
#pragma unroll
    for (int j = 0; j < 4; ++j) { const u32x2 w = xb[64 * j]; v[j] = (f32x4){bflo(w.x), bfhi(w.x), bflo(w.y), bfhi(w.y)}; }
}
__device__ __forceinline__ void xrow_store(float* out, int m, int lane, const f32x4 (&v)[4]) {
    u32x2* xb = (u32x2*)((bf16*)out + (size_t)m * 2048) + lane;
#pragma unroll
    for (int j = 0; j < 4; ++j) { u32x2 w; w.x = pk2(v[j].x, v[j].y); w.y = pk2(v[j].z, v[j].w); xb[64 * j] = w; }
}
__device__ __forceinline__ float row_rstd(const f32x4 (&v)[4]) {
    float s = 0.f;
#pragma unroll
    for (int j = 0; j < 4; ++j) s += (v[j].x * v[j].x + v[j].y * v[j].y) + (v[j].z * v[j].z + v[j].w * v[j].w);
    return rsqrtf(wave_sum(s) * (1.0f / D) + 1e-6f);
}
__device__ __forceinline__ void ph_norm1_l0(CArgs& a, int wave, int lane) {
    const int gw = blockIdx.x * NWAVES + wave, NGW = gridDim.x * NWAVES;
    const float* mod = (const float*)(a.ws + WS_MOD); bf16* ACT = (bf16*)(a.ws + WS_ACT);
    const SampleSplit q = sample_split(gw, NGW, SEQ, MC);
    ModP mp; { const float* ms = mod + (size_t)q.smp * 6144; modp_load(mp, a.in[I_N1G], ms + 1024, ms, lane); }
    for (int it = 0; it < q.nlat + q.nctx; ++it) {
        const bool isc = it >= q.nlat; const int m = isc ? ML + gw + (it - q.nlat) * NGW : q.smp * SEQ + q.wi + it * q.wps;
        if (it == q.nlat) { const float* ms = mod + (size_t)4 * 6144; modp_load(mp, a.in[I_N1G], ms + 1024, ms, lane); }
        const float* xr = m < ML ? a.in[I_X] + (size_t)m * D : a.in[I_CTX] + (size_t)(m - ML) * D;
        f32x4 v[4], h[4];
#pragma unroll
        for (int j = 0; j < 4; ++j) v[j] = __builtin_nontemporal_load((const f32x4*)xr + lane + 64 * j);
        const float rstd = row_rstd(v);
        norm_mod_store_p(v, rstd, mp, ACT + (size_t)m * D, lane, h);
    }
}

__device__ __forceinline__ int scan_row(int tau, int b, int d) {
    const bool isctx = tau < CTXL; int t = isctx ? tau : tau - CTXL;
    if (d) t = (isctx ? (CTXL - 1) : (SEQ - 1)) - t;
    return isctx ? (ML + b * CTXL + t) : (b * SEQ + t);
}
constexpr int RW_PT = 72, RW_IMG = 64 * RW_PT * 2;
constexpr int RW_NCH = (CTXL + SEQ) / 64;
constexpr int RW_CONV_SEQ = 0;
__device__ __forceinline__ bf16* rw_ops(unsigned char* ws, int it) { return (bf16*)(it < 5632 ? ws + WS_Q2 + 33 * MiB + (size_t)it * 24576 : ws + WS_ACT + (size_t)(it - 5632) * 24576); }
__device__ __forceinline__ f32x4 mfma16(bf16x8 a, bf16x8 b, f32x4 c) { return __builtin_amdgcn_mfma_f32_16x16x32_bf16(a, b, c, 0, 0, 0); }
#define RW_FRAG(img, row, k0) (*(const LAS bf16x8*)((img) + (row) * RW_PT + (k0)))
__device__ __forceinline__ void ph_rwkv_prep(CArgs& a, LAS unsigned char* lds, int tid, int wave, int lane) {
    const bf16* P = (const bf16*)(a.ws + WS_P); const bf16* Q2 = (const bf16*)(a.ws + WS_Q2);
    LAS bf16* At = (LAS bf16*)(lds + 0 * RW_IMG); LAS bf16* Bt = (LAS bf16*)(lds + 1 * RW_IMG); LAS bf16* Kt = (LAS bf16*)(lds + 2 * RW_IMG); LAS bf16* Rt = (LAS bf16*)(lds + 3 * RW_IMG);
    LAS bf16* BTr = (LAS bf16*)(lds + 4 * RW_IMG); LAS bf16* VTr = (LAS bf16*)(lds + 5 * RW_IMG); LAS bf16* LbaT = (LAS bf16*)(lds + 6 * RW_IMG); LAS bf16* LkaT = (LAS bf16*)(lds + 7 * RW_IMG);
    LAS bf16* MbrT = (LAS bf16*)(lds + 8 * RW_IMG); LAS bf16* MkrT = (LAS bf16*)(lds + 9 * RW_IMG); LAS bf16* X1 = (LAS bf16*)(lds + 10 * RW_IMG);
    LAS bf16* X0 = Bt; LAS bf16* G2T = LbaT; LAS bf16* H2T = LkaT;
    LAS bf16* Wm = (LAS bf16*)(lds + 11 * RW_IMG) + wave * 16 * 32;
    LAS bf16* DT = (LAS bf16*)(lds + 11 * RW_IMG + 8192);
    LAS float* Lf = (LAS float*)(lds + 11 * RW_IMG + 8192 + 4096);
    LAS bf16* G1img = At; LAS bf16* H1img = (LAS bf16*)(lds + 11 * RW_IMG + 18944); LAS bf16* Yimg = Kt; LAS bf16* Svimg = Rt;
    LAS float* PC = Lf + 1024;
    LAS float* SEG = PC + 64;
    LAS float* NRM = SEG + 512;
    LAS bf16* RAWr = LbaT; LAS bf16* RAWk = LkaT; LAS bf16* RAWv = MbrT; LAS bf16* RAWw = MkrT; LAS bf16* RAWa = X1;
    const int lr = lane & 15, lq = lane >> 4;
    __syncthreads();
    for (int i = tid; i < RW_IMG / 4; i += NTHREADS) ((LAS unsigned*)X1)[i] = 0u;
    for (int i = tid; i < (8192 + 4096) / 4; i += NTHREADS) ((LAS unsigned*)(lds + 11 * RW_IMG))[i] = 0u;
    u32x4 g_r, g_k, g_v, g_w, g_a;
    const bool rw_x = ((int)gridDim.x & 127) == 0;
    const int rw_R = (int)gridDim.x >> 4, rw_j = (int)blockIdx.x >> 3;
    const int rw_c = rw_x ? (rw_j & 15) : ((int)blockIdx.x & 15), rw_r = rw_x ? ((rw_j >> 4) * 8 + ((int)blockIdx.x & 7)) : ((int)blockIdx.x >> 4), h = rw_c >> 1, d = rw_c & 1;
#define RW_CHUNK(n0_) ((rw_x && d) ? ((n0_) < 4 ? 3 - (n0_) : RW_NCH + 3 - (n0_)) : (n0_))
    const int rw_q0 = rw_r < rw_R ? rw_r : 4 * RW_NCH;
    LAS bf16* BWt = (LAS bf16*)(lds + PREP_TAB); LAS float* KKt = (LAS float*)(lds + PREP_TAB + 16384); LAS float* KAt = KKt + 64; LAS float* BIt = KKt + 128;
    if ((wave & 3) == 0) { const bf16* WB_ = (const bf16*)(a.ws + WS_WB2T) + (size_t)((wave >> 2) * 1024 + d * 512 + h * 64 + lr) * 256 + (wave >> 2) * 64 + 8 * lq;
#pragma unroll
        for (int nj = 0; nj < 4; ++nj)
#pragma unroll
            for (int ks = 0; ks < 2; ++ks) *(LAS bf16x8*)(BWt + ((((wave >> 2) * 4 + nj) * 2 + ks) * 64 + lane) * 8) = *(const bf16x8*)(WB_ + (size_t)16 * nj * 256 + 32 * ks); }
    if (tid < 64) { KKt[tid] = a.in[I_KK][h * 64 + tid]; KAt[tid] = a.in[I_KA][h * 64 + tid]; }
    if (tid < 128) BIt[tid] = ((const float*)(a.ws + WS_BIAS2))[(tid >> 6) * 1024 + d * 512 + h * 64 + (tid & 63)];
#define RWP_LOAD(q_) do { const int b_ = (q_) / RW_NCH, n_ = RW_CHUNK((q_) % RW_NCH), h_ = h, d_ = d; \
        const int m_ = scan_row(64 * n_ + (tid >> 3), b_, d_); const bf16* pr_ = P + (size_t)m_ * LDP0 + h_ * 64 + 8 * (tid & 7); g_r = *(const u32x4*)(pr_ + 1024); g_k = *(const u32x4*)(pr_ + 1536); g_v = *(const u32x4*)(pr_ + 2048); \
        const int mq_ = scan_row(64 * n_ + 16 * (wave & 3) + lr, b_, d_); const bf16* qr_ = P + (size_t)mq_ * LDP0 + 2560 + (wave >> 2) * 64 + 8 * lq;     \
        g_w = *(const u32x4*)(qr_); g_a = *(const u32x4*)(qr_ + 32); } while (0)
    if (rw_q0 < 4 * RW_NCH) RWP_LOAD(rw_q0);
    { u32x4* dm_ = (u32x4*)(a.ws + WS_END + 64 * MiB) + (size_t)blockIdx.x * (4 * NTHREADS) + tid; const u32x4 z_ = (u32x4){0u, 0u, 0u, 0u};
      dm_[0] = z_; dm_[NTHREADS] = z_; dm_[2 * NTHREADS] = z_; dm_[3 * NTHREADS] = z_; }
    int kiter = 0;
    for (int q = rw_q0; q < 4 * RW_NCH; q += rw_R) {
        const int b = q / RW_NCH, n = RW_CHUNK(q % RW_NCH), seq = b * 16 + h * 2 + d, it = seq * RW_NCH + n;
        bf16* Y = (bf16*)(a.ws + (d ? WS_Y1 : WS_Y0)); bf16* ops = rw_ops(a.ws, it);
        LDS_BARRIER();
        {
            const int i = tid >> 3, c8 = 8 * (tid & 7);
            *(LAS u32x4*)(RAWr + i * RW_PT + c8) = g_r; *(LAS u32x4*)(RAWk + i * RW_PT + c8) = g_k; *(LAS u32x4*)(RAWv + i * RW_PT + c8) = g_v;
            float kf[8], kk8[8]; unpack8(g_k, kf); { const f32x4 q0 = *(const LAS f32x4*)(KKt + c8), q1 = *(const LAS f32x4*)(KKt + c8 + 4); kk8[0] = q0.x; kk8[1] = q0.y; kk8[2] = q0.z; kk8[3] = q0.w; kk8[4] = q1.x; kk8[5] = q1.y; kk8[6] = q1.z; kk8[7] = q1.w; } float ss = 0.f;
#pragma unroll
            for (int e = 0; e < 8; ++e) { const float x = kf[e] * kk8[e]; ss += x * x; }
            ss += __shfl_xor(ss, 1); ss += __shfl_xor(ss, 2); ss += __shfl_xor(ss, 4);
            if ((tid & 7) == 0) NRM[i] = rsqrtf(ss + 1e-12f);
        }
        {
            const int p_ = wave >> 2, mi = wave & 3; LAS bf16* Oi = p_ ? Bt : At;
            const bf16x8 af0 = __builtin_bit_cast(bf16x8, g_w), af1 = __builtin_bit_cast(bf16x8, g_a);
#pragma unroll
            for (int nj = 0; nj < 4; ++nj) { f32x4 acc = (f32x4){0.f, 0.f, 0.f, 0.f};
                acc = mfma16(af0, *(const LAS bf16x8*)(BWt + (((p_ * 4 + nj) * 2 + 0) * 64 + lane) * 8), acc); acc = mfma16(af1, *(const LAS bf16x8*)(BWt + (((p_ * 4 + nj) * 2 + 1) * 64 + lane) * 8), acc);
                const float bs = BIt[p_ * 64 + 16 * nj + lr];
#pragma unroll
                for (int rg = 0; rg < 4; ++rg) { const float sg = sigmoidf_(acc[rg] + bs); Oi[(16 * mi + 4 * lq + rg) * RW_PT + 16 * nj + lr] = (bf16)f2bf(p_ ? sg : -0.6065306597f * sg); } }
        }
        if (q + rw_R < 4 * RW_NCH) RWP_LOAD(q + rw_R);
        LDS_BARRIER();
        {
            const int j = lane; const float k_k = KKt[j], k_a = KAt[j];
            float r_[8], k_[8], v_[8], lw_[8], a_[8];
#pragma unroll
            for (int e = 0; e < 8; ++e) { const int o = (8 * wave + e) * RW_PT + j; r_[e] = bf2f(RAWr[o]); k_[e] = bf2f(RAWk[o]); v_[e] = bf2f(RAWv[o]); lw_[e] = bf2f(At[o]); a_[e] = bf2f(Bt[o]); }
            float c_[8]; float run = 0.f;
#pragma unroll
            for (int e = 0; e < 8; ++e) { run += lw_[e]; c_[e] = run; }
            SEG[wave * 64 + j] = run;
            LDS_BARRIER();
            float off = 0.f, tot = 0.f;
#pragma unroll
            for (int w2 = 0; w2 < 8; ++w2) { const float sg = SEG[w2 * 64 + j]; tot += sg; off += (w2 < wave) ? sg : 0.f; }
            if (wave == 0) PC[j] = __expf(tot);
            float bt_[8];
#pragma unroll
            for (int e = 0; e < 8; ++e) { const int i = 8 * wave + e; const float cum = off + c_[e]; const float Pv = __expf(cum), Pm1 = __expf(cum - lw_[e]), iP = __expf(-cum);
                const float kk = k_[e] * k_k * NRM[i];
                At[i * RW_PT + j] = (bf16)f2bf(-kk * Pm1); bt_[e] = kk * a_[e] * iP; Bt[i * RW_PT + j] = (bf16)f2bf(bt_[e]);
                Kt[i * RW_PT + j] = (bf16)f2bf(k_[e] * (1.0f + (a_[e] - 1.0f) * k_a) * iP); Rt[i * RW_PT + j] = (bf16)f2bf(r_[e] * Pv); }
            *(LAS u32x4*)(BTr + j * RW_PT + 8 * wave) = pack8(bt_);
            *(LAS u32x4*)(VTr + j * RW_PT + 8 * wave) = pack8(v_);
        }
        LDS_BARRIER();
        for (int rep_ = 0; rep_ < REPS(1); ++rep_) {
            const int p = wave >> 1; const LAS bf16* Ai = (p & 1) ? Kt : Bt; const LAS bf16* Bi = (p & 2) ? Rt : At; LAS bf16* Oi = p == 0 ? LbaT : (p == 1 ? LkaT : (p == 2 ? MbrT : MkrT)); const bool strict = p < 2;
#pragma unroll
            for (int tu = 0; tu < 8; ++tu) { const int tl = 8 * (wave & 1) + tu;
                const int mi = tl >> 2, nj = tl & 3; f32x4 acc = (f32x4){0.f, 0.f, 0.f, 0.f};
                if (mi <= nj) {
#pragma unroll
                    for (int ks = 0; ks < 2; ++ks) acc = mfma16(RW_FRAG(Ai, 16 * mi + lr, 32 * ks + 8 * lq), RW_FRAG(Bi, 16 * nj + lr, 32 * ks + 8 * lq), acc);
                    const int t = 16 * nj + lr;
#pragma unroll
                    for (int rg = 0; rg < 4; ++rg) { const int s = 16 * mi + 4 * lq + rg; const bool keep = strict ? (s < t) : (s <= t); acc[rg] = keep ? acc[rg] : 0.f; }
                    if (p == 0 && mi == nj) {
                        *(LAS f32x4*)(Lf + (mi * 16 + lr) * 16 + 4 * lq) = acc;
                        acc = (f32x4){0.f, 0.f, 0.f, 0.f};
                    }
                }
                u32x2 w; w.x = pk2(acc[0], acc[1]); w.y = pk2(acc[2], acc[3]);
                *(LAS u32x2*)(Oi + (16 * nj + lr) * RW_PT + 16 * mi + 4 * lq) = w;
            }
        }
        LDS_BARRIER();
        for (int rep_ = 0; rep_ < REPS(2); ++rep_) if (wave < 4 && lane < 16) {
            const LAS float* L = Lf + wave * 256; float x[16];
#pragma unroll
            for (int t = 0; t < 16; ++t) { float v = (lane == t) ? 1.0f : 0.0f;
#pragma unroll
                for (int u4 = 0; u4 < (t + 3) / 4; ++u4) { const f32x4 lv = *(const LAS f32x4*)(L + t * 16 + 4 * u4);
#pragma unroll
                    for (int e = 0; e < 4; ++e) if (4 * u4 + e < t) v += x[4 * u4 + e] * lv[e]; }
                x[t] = v; DT[(wave * 16 + t) * 32 + lane] = (bf16)f2bf(v); }
        }
        LDS_BARRIER();
        for (int rep_ = 0; rep_ < REPS(3); ++rep_) {
            LAS bf16* Xi = wave < 4 ? X0 : X1; const int rb = 16 * (wave & 3);
            const LAS bf16* Zi = wave < 4 ? At : LkaT;
#pragma unroll
            for (int c = 0; c < 4; ++c) {
                f32x4 acc; { const u32x2 z = *(const LAS u32x2*)(Zi + (16 * c + lr) * RW_PT + rb + 4 * lq); acc[0] = bflo(z.x); acc[1] = bfhi(z.x); acc[2] = bflo(z.y); acc[3] = bfhi(z.y); }
#pragma unroll
                for (int ks = 0; ks < (c + 1) / 2; ++ks) acc = mfma16(RW_FRAG(Xi, rb + lr, 32 * ks + 8 * lq), RW_FRAG(LbaT, 16 * c + lr, 32 * ks + 8 * lq), acc);
#pragma unroll
                for (int rg = 0; rg < 4; ++rg) Wm[(4 * lq + rg) * 32 + lr] = (bf16)f2bf(acc[rg]);
                asm volatile("s_waitcnt lgkmcnt(0)" ::: "memory");
                f32x4 xc = mfma16(*(const LAS bf16x8*)(Wm + lr * 32 + 8 * lq), *(const LAS bf16x8*)(DT + (c * 16 + lr) * 32 + 8 * lq), (f32x4){0.f, 0.f, 0.f, 0.f});
#pragma unroll
                for (int rg = 0; rg < 4; ++rg) Xi[(rb + 4 * lq + rg) * RW_PT + 16 * c + lr] = (bf16)f2bf(xc[rg]);
                asm volatile("s_waitcnt lgkmcnt(0)" ::: "memory");
            }
        }
        LDS_BARRIER();
        for (int rep_ = 0; rep_ < REPS(4); ++rep_) {
            const int q = wave >> 1; const LAS bf16* Ai = (q & 1) ? X1 : X0; const LAS bf16* Bi = (q & 2) ? BTr : MbrT;
#pragma unroll
            for (int tu = 0; tu < 8; ++tu) { const int tl = 8 * (wave & 1) + tu;
                const int mi = tl >> 2, nj = tl & 3; f32x4 acc = (f32x4){0.f, 0.f, 0.f, 0.f};
#pragma unroll
                for (int ks = 0; ks < 2; ++ks) acc = mfma16(RW_FRAG(Ai, 16 * mi + lr, 32 * ks + 8 * lq), RW_FRAG(Bi, 16 * nj + lr, 32 * ks + 8 * lq), acc);
                const int col = 16 * nj + lr, row0 = 16 * mi + 4 * lq;
                if (q == 0) { const u32x2 z = *(const LAS u32x2*)(Rt + col * RW_PT + row0); u32x2 w; w.x = pk2(acc[0] + bflo(z.x), acc[1] + bfhi(z.x)); w.y = pk2(acc[2] + bflo(z.y), acc[3] + bfhi(z.y));
                    *(LAS u32x2*)(G1img + col * RW_PT + row0) = w; }
                else if (q == 1) { const u32x2 z = *(const LAS u32x2*)(MkrT + col * RW_PT + row0); u32x2 w; w.x = pk2(acc[0] + bflo(z.x), acc[1] + bfhi(z.x)); w.y = pk2(acc[2] + bflo(z.y), acc[3] + bfhi(z.y));
                    *(LAS u32x2*)(G2T + col * RW_PT + row0) = w; }
                else if (q == 2) { const float pc = PC[col]; u32x2 w; w.x = pk2((acc[0] + (row0 == col ? 1.f : 0.f)) * pc, (acc[1] + (row0 + 1 == col ? 1.f : 0.f)) * pc); w.y = pk2((acc[2] + (row0 + 2 == col ? 1.f : 0.f)) * pc, (acc[3] + (row0 + 3 == col ? 1.f : 0.f)) * pc);
                    *(LAS u32x2*)(H1img + col * RW_PT + row0) = w; }
                else { const float pc = PC[col]; u32x2 w; w.x = pk2((acc[0] + bf2f(Kt[(row0 + 0) * RW_PT + col])) * pc, (acc[1] + bf2f(Kt[(row0 + 1) * RW_PT + col])) * pc); w.y = pk2((acc[2] + bf2f(Kt[(row0 + 2) * RW_PT + col])) * pc, (acc[3] + bf2f(Kt[(row0 + 3) * RW_PT + col])) * pc);
                    *(LAS u32x2*)(H2T + col * RW_PT + row0) = w; }
            }
        }
        LDS_BARRIER();
        for (int rep_ = 0; rep_ < REPS(5); ++rep_) {
            { const int row = tid >> 3, c8 = 8 * (tid & 7); *((u32x4*)ops + tid) = *(const LAS u32x4*)(G1img + row * RW_PT + c8); *((u32x4*)(ops + 4096) + tid) = *(const LAS u32x4*)(H1img + row * RW_PT + c8); }
            const int q = wave >> 2; const LAS bf16* Ai = q ? H2T : VTr; const LAS bf16* Bi = q ? VTr : G2T; LAS bf16* Oi = q ? Svimg : Yimg;
#pragma unroll
            for (int tu = 0; tu < 4; ++tu) { const int tl = 4 * (wave & 3) + tu;
                const int mi = tl >> 2, nj = tl & 3; f32x4 acc = (f32x4){0.f, 0.f, 0.f, 0.f};
#pragma unroll
                for (int ks = 0; ks < 2; ++ks) acc = mfma16(RW_FRAG(Ai, 16 * mi + lr, 32 * ks + 8 * lq), RW_FRAG(Bi, 16 * nj + lr, 32 * ks + 8 * lq), acc);
                const int col = 16 * nj + lr, row0 = 16 * mi + 4 * lq; u32x2 w; w.x = pk2(acc[0], acc[1]); w.y = pk2(acc[2], acc[3]);
                *(LAS u32x2*)(Oi + col * RW_PT + row0) = w;
            }
        }
        LDS_BARRIER();
        { const int row = tid >> 3, c8 = 8 * (tid & 7); const int m = scan_row(64 * n + row, b, d);
            *(u32x4*)(Y + (size_t)m * 512 + h * 64 + c8) = *(const LAS u32x4*)(Yimg + row * RW_PT + c8); *((u32x4*)(ops + 8192) + tid) = *(const LAS u32x4*)(Svimg + row * RW_PT + c8); }
        const int cbase = RW_CONV_SEQ;
        if (kiter % 4 == 0) { const int cit = cbase + (kiter / 4) * (int)(gridDim.x * NWAVES) + (int)blockIdx.x * NWAVES + wave;
            int lane_ = lane; asm volatile("" : "+v"(lane_));
            if (cit < 16 * 1152) moe_convert_item<32>(a, 0, cit, wave < 7 ? lds + (4 + wave) * RW_IMG : lds, lane_); }
        ++kiter;
    }
    __syncthreads();
    for (int cit = RW_CONV_SEQ + ((kiter + 3) / 4) * (int)(gridDim.x * NWAVES) + (int)blockIdx.x * NWAVES + wave; cit < 16 * 1152; cit += (int)(gridDim.x * NWAVES)) moe_convert_item(a, 0, cit, lds + wave * 8192, lane);
}
__device__ __forceinline__ void ph_rwkv_seq(CArgs& a, LAS unsigned char* lds, int tid, int wave, int lane) {
    const int lr = lane & 15, lq = lane >> 4;
    const bool xmap = (int)gridDim.x == 256;
    for (int pass_ = 0; pass_ < REPS(12); ++pass_)
    for (int task = blockIdx.x; task < 256; task += gridDim.x) {
        const ptrdiff_t yshift_ = (pass_ == REPS(12) - 1) ? 0 : (ptrdiff_t)((a.ws + WS_END) - (a.ws + WS_Y0)) / 2;
        const int it = xmap ? ((task >> 3) & 3) : (task & 3), seq = xmap ? ((task & 7) + 8 * (task >> 5)) : (task >> 2);
        const int b = seq >> 4, h = (seq >> 1) & 7, d = seq & 1;
        bf16* Y = (bf16*)(a.ws + (d ? WS_Y1 : WS_Y0));
        constexpr int SIMG = 16 * RW_PT * 2;
        __syncthreads();
        for (int i = tid; i < 2 * SIMG / 4; i += NTHREADS) ((LAS unsigned*)lds)[i] = 0u;
        __syncthreads();
        constexpr int RW_PD = 6;
        static_assert(RW_NCH % RW_PD == 0, "ring depth must divide the chunk count");
        bf16x8 fr[RW_PD][2]; u32x2 ad[RW_PD];
        const int w4 = wave & 3; const bool ywave = wave >= 4;
#define RW_SEQ_LOAD(s_, n_) do { const int nn_ = (n_) < RW_NCH ? (n_) : RW_NCH - 1; const bf16* ops_ = rw_ops(a.ws, seq * RW_NCH + nn_); \
            const bf16* fp_ = ops_ + (ywave ? 0 : 4096) + (16 * w4 + lr) * 64 + 8 * lq; fr[s_][0] = *(const bf16x8*)fp_; fr[s_][1] = *(const bf16x8*)(fp_ + 32); \
            const int m_ = scan_row(64 * nn_ + 16 * w4 + lr, b, d); \
            const bf16* ap_ = ywave ? (const bf16*)(Y + (size_t)m_ * 512 + h * 64 + 16 * it + 4 * lq) : ops_ + 8192 + (16 * it + lr) * 64 + 16 * w4 + 4 * lq; \
            ad[s_] = *(const u32x2*)ap_; } while (0)
#pragma unroll
        for (int s_ = 0; s_ < RW_PD; ++s_) RW_SEQ_LOAD(s_, s_);
#pragma unroll 1
        for (int n0 = 0; n0 < RW_NCH; n0 += RW_PD) {
#pragma unroll
          for (int s_ = 0; s_ < RW_PD; ++s_) { const int n = n0 + s_;
            const LAS bf16* Sc = (const LAS bf16*)(lds + (n & 1) * SIMG); LAS bf16* Sn = (LAS bf16*)(lds + ((n & 1) ^ 1) * SIMG);
            const bf16x8 sf0 = RW_FRAG(Sc, lr, 8 * lq), sf1 = RW_FRAG(Sc, lr, 32 + 8 * lq);
            f32x4 acc = (f32x4){bflo(ad[s_].x), bfhi(ad[s_].x), bflo(ad[s_].y), bfhi(ad[s_].y)};
            if (!ywave) {
                acc = mfma16(fr[s_][0], sf0, acc); acc = mfma16(fr[s_][1], sf1, acc);
                u32x2 w; w.x = pk2(acc[0], acc[1]); w.y = pk2(acc[2], acc[3]); *(LAS u32x2*)(Sn + lr * RW_PT + 16 * w4 + 4 * lq) = w;
            } else {
                acc = mfma16(sf0, fr[s_][0], acc); acc = mfma16(sf1, fr[s_][1], acc);
                const int m_ = scan_row(64 * n + 16 * w4 + lr, b, d);
                u32x2 w; w.x = pk2(acc[0], acc[1]); w.y = pk2(acc[2], acc[3]); *(u32x2*)(Y + yshift_ + (size_t)m_ * 512 + h * 64 + 16 * it + 4 * lq) = w;
            }
            __builtin_amdgcn_sched_barrier(0);
            RW_SEQ_LOAD(s_, n + RW_PD);
            LDS_BARRIER();
          }
        }
#undef RW_SEQ_LOAD
    }
}

__device__ __forceinline__ void ph_rwkv_readout(CArgs& a, int wave, int lane) {
    const int gw = blockIdx.x * NWAVES + wave, NGW = gridDim.x * NWAVES;
    const bf16* P = (const bf16*)(a.ws + WS_P); const bf16* Q2 = (const bf16*)(a.ws + WS_Q2);
    const bf16* Y0 = (const bf16*)(a.ws + WS_Y0); const bf16* Y1 = (const bf16*)(a.ws + WS_Y1); bf16* ACT = (bf16*)(a.ws + WS_ACT);
    const int c8 = 8 * lane;
    float cw0[8], cw1[8], cw2[8], lng[8], lnb[8], rk[8];
    load8f(a.in[I_CONVW] + c8, cw0); load8f(a.in[I_CONVW] + 512 + c8, cw1); load8f(a.in[I_CONVW] + 1024 + c8, cw2);
    load8f(a.in[I_LNG] + c8, lng); load8f(a.in[I_LNB] + c8, lnb); load8f(a.in[I_RK] + c8, rk);
    for (int m = gw; m < MT; m += NGW) {
        int t, L; if (m < ML) { t = m & (SEQ - 1); L = SEQ; } else { t = (m - ML) & (CTXL - 1); L = CTXL; }
        const bf16* pr = P + (size_t)m * LDP0;
        const u32x4 z4 = (u32x4){0u, 0u, 0u, 0u};
        float gu[8], gb[8], gup[8], gun[8], o[8];
        unpack8(*(const u32x4*)(pr + c8), gu); unpack8(__builtin_nontemporal_load((const u32x4*)(pr + 512 + c8)), gb);
        unpack8(t > 0 ? *(const u32x4*)(pr - LDP0 + c8) : z4, gup); unpack8(t < L - 1 ? *(const u32x4*)(pr + LDP0 + c8) : z4, gun);
#pragma unroll
        for (int i = 0; i < 8; ++i) o[i] = gb[i] * (cw0[i] * gup[i] + cw1[i] * gu[i] + cw2[i] * gun[i]);
        *(u32x4*)(ACT + (size_t)m * D + c8) = pack8(o);
        float y0[8], y1[8], r[8], k[8], v[8], g[8];
        unpack8(__builtin_nontemporal_load((const u32x4*)(Y0 + (size_t)m * 512 + c8)), y0); unpack8(__builtin_nontemporal_load((const u32x4*)(Y1 + (size_t)m * 512 + c8)), y1);
        unpack8(__builtin_nontemporal_load((const u32x4*)(pr + 1024 + c8)), r); unpack8(__builtin_nontemporal_load((const u32x4*)(pr + 1536 + c8)), k); unpack8(__builtin_nontemporal_load((const u32x4*)(pr + 2048 + c8)), v);
        unpack8(__builtin_nontemporal_load((const u32x4*)(Q2 + (size_t)m * 512 + c8)), g);
        float s = 0.f, bs = 0.f;
#pragma unroll
        for (int i = 0; i < 8; ++i) { y0[i] += y1[i]; s += y0[i]; bs += r[i] * k[i] * rk[i]; }
        s += __shfl_xor(s, 1); s += __shfl_xor(s, 2); s += __shfl_xor(s, 4);
        bs += __shfl_xor(bs, 1); bs += __shfl_xor(bs, 2); bs += __shfl_xor(bs, 4);
        const float mu = s * (1.0f / 64.0f); float q = 0.f;
#pragma unroll
        for (int i = 0; i < 8; ++i) { y0[i] -= mu; q += y0[i] * y0[i]; }
        q += __shfl_xor(q, 1); q += __shfl_xor(q, 2); q += __shfl_xor(q, 4);
        const float rstd = rsqrtf(q * (1.0f / 64.0f) + 64e-5f);
#pragma unroll
        for (int i = 0; i < 8; ++i) o[i] = (y0[i] * rstd * lng[i] + lnb[i] + bs * v[i]) * g[i];
        *(u32x4*)(ACT + (size_t)m * D + 512 + c8) = pack8(o);
    }
}

__device__ __forceinline__ void ph_norm2_router(CArgs& a, int l, int Mrows, LAS unsigned char* lds, int tid, int wave, int lane) {
    LAS float* rtT = (LAS float*)lds;
    const float* R = a.in[I_ROUTER] + (size_t)l * D * 16;
    __syncthreads();
    for (int i = tid; i < D * 16; i += NTHREADS) { const int c = i >> 4, e = i & 15; rtT[e * 1024 + c] = R[i]; }
    __syncthreads();
    const int gw = blockIdx.x * NWAVES + wave, NGW = gridDim.x * NWAVES;
    const float* mod = (const float*)(a.ws + WS_MOD); bf16* ACT = (bf16*)(a.ws + WS_ACT); float* AFF = (float*)(a.ws + WS_AFF);
    const float* XC = (const float*)(a.ws + WS_XC);
    const bool b5 = (lane & 32) != 0, b4 = (lane & 16) != 0, b3 = (lane & 8) != 0, b2 = (lane & 4) != 0;
    const int myexp = (b5 ? 8 : 0) | (b4 ? 4 : 0) | (b3 ? 2 : 0) | (b2 ? 1 : 0);
    const SampleSplit q = sample_split(gw, NGW, SEQ / 4, (Mrows - ML) / 4);
    ModP mp; { const float* ms = mod + (size_t)(l * 5 + q.smp) * 6144; modp_load(mp, a.in[I_N2G] + l * D, ms + 4096, ms + 3072, lane); }
    for (int it = 0; it < q.nlat + q.nctx; ++it) {
        const bool isc = it >= q.nlat; const int grp = isc ? ML / 4 + gw + (it - q.nlat) * NGW : q.smp * (SEQ / 4) + q.wi + it * q.wps;
        if (it == q.nlat) { const float* ms = mod + (size_t)(l * 5 + 4) * 6144; modp_load(mp, a.in[I_N2G] + l * D, ms + 4096, ms + 3072, lane); }
        f32x4 h[4][4];
#pragma unroll
        for (int rr = 0; rr < 4; ++rr) { const int m = 4 * grp + rr;
            if (m < ML) xrow_load(a.out, m, lane, h[rr]);
            else { const float* xr = (l == 0 ? a.in[I_CTX] : XC) + (size_t)(m - ML) * D;
#pragma unroll
                for (int j = 0; j < 4; ++j) h[rr][j] = *((const f32x4*)xr + lane + 64 * j); } }
        if (l == 0 && 4 * grp >= ML) {
            const float* XPC = (const float*)(a.ws + WS_XPC); float* XCw = (float*)(a.ws + WS_XC);
#pragma unroll
            for (int rr = 0; rr < 4; ++rr) { const int r = 4 * grp + rr - ML;
#pragma unroll
                for (int j = 0; j < 4; ++j) { const f32x4* pp = (const f32x4*)(XPC + (size_t)r * D) + lane + 64 * j;
                    const f32x4 sm = (pp[0] + pp[(size_t)MC * D / 4]) + (pp[(size_t)2 * MC * D / 4] + pp[(size_t)3 * MC * D / 4]);
                    const f32x4 g1 = *((const f32x4*)(mod + (size_t)4 * 6144 + 2048) + lane + 64 * j);
                    h[rr][j] = h[rr][j] + g1 * sm; *((f32x4*)(XCw + (size_t)r * D) + lane + 64 * j) = h[rr][j]; } }
        }
#pragma unroll
        for (int rr = 0; rr < 4; ++rr) { const int m = 4 * grp + rr; f32x4 v[4];
#pragma unroll
            for (int j = 0; j < 4; ++j) v[j] = h[rr][j];
            const float rstd = row_rstd(v);
            norm_mod_store_p(v, rstd, mp, ACT + (size_t)m * D, lane, h[rr]); }
        float q1v[4];
#define RT_DOT(e_, out_) do { f32x4 rv_[4]; _Pragma("unroll") for (int j = 0; j < 4; ++j) rv_[j] = *(const LAS f32x4*)(rtT + (e_) * 1024 + 4 * lane + 256 * j); \
            _Pragma("unroll") for (int rr = 0; rr < 4; ++rr) { f32x2 a2_ = (f32x2){0.f, 0.f};        \
                _Pragma("unroll") for (int j = 0; j < 4; ++j) { a2_ += __builtin_shufflevector(h[rr][j], h[rr][j], 0, 1) * __builtin_shufflevector(rv_[j], rv_[j], 0, 1); \
                    a2_ += __builtin_shufflevector(h[rr][j], h[rr][j], 2, 3) * __builtin_shufflevector(rv_[j], rv_[j], 2, 3); } \
                out_[rr] = a2_.x + a2_.y; } } while (0)
        {
            float q2v[2][4];
#pragma unroll
            for (int c = 0; c < 2; ++c) {
                float q4v[2][4];
#pragma unroll
                for (int bs = 0; bs < 2; ++bs) {
                    float q8v[2][4];
#pragma unroll
                    for (int as = 0; as < 2; ++as) { const int k8 = c + 2 * bs + 4 * as; float pa[4], pb[4];
                        RT_DOT(k8, pa); RT_DOT(k8 + 8, pb);
#pragma unroll
                        for (int rr = 0; rr < 4; ++rr) { const float keep = b5 ? pb[rr] : pa[rr], send = b5 ? pa[rr] : pb[rr]; q8v[as][rr] = keep + __shfl_xor(send, 32); }
                        asm volatile("" ::: "memory"); }
#pragma unroll
                    for (int rr = 0; rr < 4; ++rr) { const float keep = b4 ? q8v[1][rr] : q8v[0][rr], send = b4 ? q8v[0][rr] : q8v[1][rr]; q4v[bs][rr] = keep + __shfl_xor(send, 16); }
                }
#pragma unroll
                for (int rr = 0; rr < 4; ++rr) { const float keep = b3 ? q4v[1][rr] : q4v[0][rr], send = b3 ? q4v[0][rr] : q4v[1][rr]; q2v[c][rr] = keep + __shfl_xor(send, 8); }
            }
#pragma unroll
            for (int rr = 0; rr < 4; ++rr) { const float keep = b2 ? q2v[1][rr] : q2v[0][rr], send = b2 ? q2v[0][rr] : q2v[1][rr]; q1v[rr] = keep + __shfl_xor(send, 4); }
        }
#undef RT_DOT
#pragma unroll
        for (int rr = 0; rr < 4; ++rr) {
            float q1 = q1v[rr];
            q1 += __shfl_xor(q1, 2); q1 += __shfl_xor(q1, 1);
            float mx = q1; mx = fmaxf(mx, __shfl_xor(mx, 4)); mx = fmaxf(mx, __shfl_xor(mx, 8)); mx = fmaxf(mx, __shfl_xor(mx, 16)); mx = fmaxf(mx, __shfl_xor(mx, 32));
            const float ex = __expf(q1 - mx);
            float den = ex; den += __shfl_xor(den, 4); den += __shfl_xor(den, 8); den += __shfl_xor(den, 16); den += __shfl_xor(den, 32);
            if ((lane & 3) == 0) AFF[(size_t)(4 * grp + rr) * 16 + myexp] = ex * __builtin_amdgcn_rcpf(den);
        }
    }
}

__device__ __forceinline__ int block_excl_scan(int v, LAS int* tmp, int wave, int lane, int& total) {
    int inc = v;
#pragma unroll
    for (int o = 1; o < 64; o <<= 1) { const int t = __shfl_up(inc, o); if (lane >= o) inc += t; }
    if (lane == 63) tmp[wave] = inc;
    __syncthreads();
    int base = 0, tot = 0;
#pragma unroll
    for (int w = 0; w < NWAVES; ++w) { const int x = tmp[w]; if (w < wave) base += x; tot += x; }
    __syncthreads();
    total = tot; return base + inc - v;
}
__device__ __forceinline__ void ph_topk(CArgs& a, int l, LAS unsigned char* lds, int tid, int wave, int lane) {
    LAS unsigned* keys = (LAS unsigned*)lds;
    LAS int* hist = (LAS int*)(lds + 32768);
    LAS int* sfx = hist + 256;
    LAS int* tmp = sfx + 264;
    LAS int* bc = tmp + 8;
    const float* AFF = (const float*)(a.ws + WS_AFF); int* INV = (int*)(a.ws + WS_INV); int* IDX = (int*)(a.ws + WS_IDX);
    const int nitems = l == 0 ? 128 : 64, RPE = l == 0 ? RPE0 : RPE1;
    for (int item = blockIdx.x; item < nitems; item += gridDim.x) {
        const bool lat = item < 64; const int b = (item & 63) >> 4, e = item & 15;
        const int T = lat ? SEQ : CTXL, cap = T / 8, row0 = lat ? b * SEQ : ML + b * CTXL, segbase = lat ? b * 1024 : 4096 + b * 32;
        __syncthreads();
        for (int i = tid; i < T; i += NTHREADS) keys[i] = __float_as_uint(AFF[(size_t)(row0 + i) * 16 + e]);
        unsigned prefix = 0u, mask = 0u; int kk = cap;
        for (int pass = 0; pass < 4; ++pass) {
            const int shift = 24 - 8 * pass;
            if (tid < 256) hist[tid] = 0;
            __syncthreads();
            for (int i = tid; i < T; i += NTHREADS) { const unsigned k = keys[i]; if ((k & mask) == prefix) __hip_atomic_fetch_add(&hist[(k >> shift) & 255u], 1, __ATOMIC_RELAXED, __HIP_MEMORY_SCOPE_WORKGROUP); }
            __syncthreads();
            if (tid < 256) { int s = 0; for (int q = tid; q < 256; ++q) s += hist[q]; sfx[tid] = s; } else if (tid == 256) sfx[256] = 0;
            __syncthreads();
            if (tid < 256) { const int s0 = sfx[tid], s1 = sfx[tid + 1]; if (s0 >= kk && s1 < kk) { bc[0] = tid; bc[1] = kk - s1; } }
            __syncthreads();
            prefix |= ((unsigned)bc[0]) << shift; mask |= 0xffu << shift; kk = bc[1];
            __syncthreads();
        }
        const unsigned thr = prefix; const int need = kk;
        const int i0 = 16 * tid; int ceq = 0;
        unsigned kv[16];
#pragma unroll
        for (int i = 0; i < 16; ++i) { kv[i] = (i0 + i < T) ? keys[i0 + i] : 0u; ceq += (i0 + i < T && kv[i] == thr) ? 1 : 0; }
        int tot; int eqr = block_excl_scan(ceq, tmp, wave, lane, tot);
        int nsel = 0; unsigned selmask = 0u;
#pragma unroll
        for (int i = 0; i < 16; ++i) { bool sel = false; if (i0 + i < T) { if (kv[i] > thr) sel = true; else if (kv[i] == thr) { sel = eqr < need; ++eqr; } } if (sel) { selmask |= 1u << i; ++nsel; } }
        int slot = segbase + block_excl_scan(nsel, tmp, wave, lane, tot);
#pragma unroll
        for (int i = 0; i < 16; ++i) if (i0 + i < T) { const int row = row0 + i0 + i; if (selmask & (1u << i)) { IDX[e * RPE + slot] = row; INV[(size_t)row * 16 + e] = slot; ++slot; } else INV[(size_t)row * 16 + e] = -1; }
        if (l == 0 && lat && b == 0 && tid < 128) IDX[e * RPE + 4224 + tid] = 0;
    }
}

__device__ __forceinline__ void ph_gather(CArgs& a, int l, int wave, int lane) {
    const int gw = blockIdx.x * NWAVES + wave, NGW = gridDim.x * NWAVES;
    const bf16* ACT = (const bf16*)(a.ws + WS_ACT); bf16* XIN = (bf16*)(a.ws + WS_Q2); const int* IDX = (const int*)(a.ws + WS_IDX);
    const int nrows = 16 * (l == 0 ? RPE0 : RPE1);
    for (int r = gw; r < nrows; r += NGW) {
        const int src = IDX[r];
        const u32x4* s = (const u32x4*)(ACT + (size_t)src * D) + lane; u32x4* d = (u32x4*)(XIN + (size_t)r * D) + lane;
        const u32x4 x0 = s[0], x1 = s[64]; d[0] = x0; d[64] = x1;
    }
}

template <bool NEXTNORM>
__device__ __forceinline__ void ph_combine(CArgs& a, int l, int Mrows, int wave, int lane) {
    const int gw = blockIdx.x * NWAVES + wave, NGW = gridDim.x * NWAVES;
    const float* mod = (const float*)(a.ws + WS_MOD); bf16* ACT = (bf16*)(a.ws + WS_ACT); const float* AFF = (const float*)(a.ws + WS_AFF);
    const int* INV = (const int*)(a.ws + WS_INV); const bf16* YE = (const bf16*)(a.ws + WS_Q2); float* XC = (float*)(a.ws + WS_XC);
    const int RPE = l == 0 ? RPE0 : RPE1;
    const SampleSplit q = sample_split(gw, NGW, SEQ / 4, (Mrows - ML) / 4);
    ModP mp; f32x4 g2v[4];
#define CMB_PARAMS(smp_) do { const float* ms_ = mod + (size_t)(l * 5 + (smp_)) * 6144; _Pragma("unroll") for (int j = 0; j < 4; ++j) g2v[j] = *((const f32x4*)(ms_ + 5120) + lane + 64 * j); \
        if (NEXTNORM) { const float* ms1_ = mod + (size_t)(1 * 5 + (smp_)) * 6144; modp_load(mp, a.in[I_N1G] + D, ms1_ + 1024, ms1_, lane); } } while (0)
    CMB_PARAMS(q.smp);
    for (int it = 0; it < q.nlat + q.nctx; ++it) {
        const bool isc = it >= q.nlat; const int grp = isc ? ML / 4 + gw + (it - q.nlat) * NGW : q.smp * (SEQ / 4) + q.wi + it * q.wps;
        if (it == q.nlat) CMB_PARAMS(4);
        f32x4 acc[4][4], xv[4][4]; int myinv[4]; float myaff[4]; unsigned long long msk[4];
#pragma unroll
        for (int rr = 0; rr < 4; ++rr) { const int m = 4 * grp + rr;
            myinv[rr] = lane < 16 ? INV[(size_t)m * 16 + lane] : -1; myaff[rr] = lane < 16 ? AFF[(size_t)m * 16 + lane] : 0.f;
            if (m < ML) xrow_load(a.out, m, lane, xv[rr]);
            else { const float* xr = XC + (size_t)(m - ML) * D;
#pragma unroll
                for (int j = 0; j < 4; ++j) xv[rr][j] = *((const f32x4*)xr + lane + 64 * j); }
#pragma unroll
            for (int j = 0; j < 4; ++j) acc[rr][j] = (f32x4){0.f, 0.f, 0.f, 0.f}; }
#pragma unroll
        for (int rr = 0; rr < 4; ++rr) msk[rr] = __ballot(myinv[rr] >= 0);
        const bool split = NEXTNORM && 4 * grp >= ML;
        const bf16* YEC = (const bf16*)(a.ws + WS_YEC);
        while ((msk[0] | msk[1] | msk[2] | msk[3]) != 0ull) {
            float gt[4]; const bf16* yb[4];
#pragma unroll
            for (int rr = 0; rr < 4; ++rr) {
                gt[rr] = 0.f; yb[rr] = nullptr;
                if (msk[rr] != 0ull) { const int e = __builtin_ctzll(msk[rr]); msk[rr] &= msk[rr] - 1ull;
                    const int slot = __builtin_amdgcn_readlane(myinv[rr], e); gt[rr] = __builtin_bit_cast(float, __builtin_amdgcn_readlane(__builtin_bit_cast(int, myaff[rr]), e));
                    yb[rr] = split ? YEC + ((size_t)e * 128 + (slot - 4096)) * D : YE + ((size_t)e * RPE + slot) * D; }
            }
            const int nkq = split ? 4 : 1;
#pragma unroll 1
            for (int kq = 0; kq < nkq; ++kq) {
                unsigned long long w[4][4];
#pragma unroll
                for (int rr = 0; rr < 4; ++rr) {
#pragma unroll
                    for (int j = 0; j < 4; ++j) w[rr][j] = 0ull;
                    if (yb[rr] != nullptr) { const unsigned long long* yr = (const unsigned long long*)(yb[rr] + (size_t)kq * 16 * 128 * D) + lane;
#pragma unroll
                        for (int j = 0; j < 4; ++j) w[rr][j] = __builtin_nontemporal_load(yr + 64 * j); }
                }
#pragma unroll
                for (int rr = 0; rr < 4; ++rr)
#pragma unroll
                    for (int j = 0; j < 4; ++j) { const unsigned lo = (unsigned)w[rr][j], hi = (unsigned)(w[rr][j] >> 32); const float g = gt[rr];
                        acc[rr][j].x += g * bflo(lo); acc[rr][j].y += g * bfhi(lo); acc[rr][j].z += g * bflo(hi); acc[rr][j].w += g * bfhi(hi); }
            }
        }
#pragma unroll
        for (int rr = 0; rr < 4; ++rr) { const int m = 4 * grp + rr;
            f32x4 v[4], h[4];
#pragma unroll
            for (int j = 0; j < 4; ++j) v[j] = xv[rr][j] + g2v[j] * acc[rr][j];
            if (m >= ML) { float* xr = XC + (size_t)(m - ML) * D;
#pragma unroll
                for (int j = 0; j < 4; ++j) *((f32x4*)xr + lane + 64 * j) = v[j]; }
            else if (NEXTNORM) xrow_store(a.out, m, lane, v);
            else { float* xr = a.out + (size_t)m * D;
#pragma unroll
                for (int j = 0; j < 4; ++j) __builtin_nontemporal_store(v[j], (f32x4*)xr + lane + 64 * j); }
            if (NEXTNORM) {
                const float rstd = row_rstd(v);
                norm_mod_store_p(v, rstd, mp, ACT + (size_t)m * D, lane, h);
            }
        }
    }
#undef CMB_PARAMS
}

__device__ __forceinline__ f32x16 mfma32(bf16x8 a, bf16x8 b, f32x16 c) { return __builtin_amdgcn_mfma_f32_32x32x16_bf16(a, b, c, 0, 0, 0); }
__device__ __forceinline__ float logsigmoidf_(float x) { return fminf(x, 0.f) - __logf(1.0f + __expf(-fabsf(x))); }

#define GLA_CG(n) ((n) < 4 ? 512 + 4 * b + (d == 0 ? (n) : 3 - (n)) : 128 * b + (d == 0 ? (n) - 4 : 127 - ((n) - 4)))
__device__ __forceinline__ void ph_l1_prep(CArgs& a, LAS unsigned char* lds, int tid, int wave, int lane) {
    const bf16* P = (const bf16*)(a.ws + WS_P);
    const int G = gridDim.x, bid = blockIdx.x;
    {
        bf16* QF = (bf16*)(a.ws + WS_QF); bf16* KF = (bf16*)(a.ws + WS_KF); bf16* VF = (bf16*)(a.ws + WS_VF);
        const int nskip = (G > 64 && 1056 % G != 0) ? (1056 % G) : 0;
        const int gw = (bid - nskip) * NWAVES + wave, NGW = (G - nskip) * NWAVES;
        const int tok = lane & 31, hf = lane >> 5;
        LAS bf16* Tv = (LAS bf16*)(lds + wave * 4608);
        __syncthreads();
        float gnk[4][8], gnq[4][8];
#pragma unroll
        for (int e = 0; e < 4; ++e) { load8f(a.in[I_KNG] + 32 * hf + 8 * e, gnk[e]); load8f(a.in[I_QNG] + 32 * hf + 8 * e, gnq[e]); }
        for (int rep_ = 0; rep_ < REPS(6); ++rep_)
        for (int it = (bid >= nskip ? gw : 1056 * 8); it < 1056 * 8; it += NGW) {
            const int tc = it >> 3, h = it & 7;
            const bool lat = tc < 1024; const int b = lat ? (tc >> 8) : ((tc - 1024) >> 3), kc = lat ? (tc & 255) : (256 + ((tc - 1024) & 7));
            const size_t m = (size_t)32 * tc + tok;
#pragma unroll
            for (int which = 0; which < 2; ++which) {
                if (which == 1 && !lat) break;
                const bf16* src = P + m * NIN + (which == 0 ? 512 : 0) + h * 64 + 32 * hf;
                float f[4][8]; float ss = 0.f;
#pragma unroll
                for (int e = 0; e < 4; ++e) { unpack8(*(const u32x4*)(src + 8 * e), f[e]);
#pragma unroll
                    for (int i = 0; i < 8; ++i) ss += f[e][i] * f[e][i]; }
                ss += __shfl_xor(ss, 32);
                const float rstd = rsqrtf(ss * (1.0f / 64.0f) + 1e-6f) * (which == 1 ? 0.125f * 1.44269504f : 1.0f);
                bf16* dst = which == 0 ? KF + ((size_t)((b * 8 + h) * 264 + kc) * 4) * 512 : QF + ((size_t)((b * 8 + h) * 256 + kc) * 4) * 512;
#pragma unroll
                for (int e = 0; e < 4; ++e) { float o[8];
#pragma unroll
                    for (int i = 0; i < 8; ++i) o[i] = f[e][i] * rstd * (which == 0 ? gnk[e][i] : gnq[e][i]);
                    const int s = 2 * hf + (e >> 1), hp = e & 1;
                    *(u32x4*)(dst + ((size_t)s * 64 + tok + 32 * hp) * 8) = pack8(o); }
            }
            { const bf16* src = P + m * NIN + 1024 + h * 64 + 32 * hf;
#pragma unroll
              for (int e = 0; e < 4; ++e) *(LAS u32x4*)(Tv + tok * 72 + 32 * hf + 8 * e) = *(const u32x4*)(src + 8 * e); }
            asm volatile("s_waitcnt lgkmcnt(0)" ::: "memory");
            bf16* vdst = VF + ((size_t)((b * 8 + h) * 264 + kc) * 4) * 512;
#pragma unroll
            for (int mt = 0; mt < 2; ++mt)
#pragma unroll
                for (int s = 0; s < 2; ++s) { u32x4 w; unsigned o[8];
#pragma unroll
                    for (int j = 0; j < 8; ++j) o[j] = Tv[(16 * s + 8 * (j >> 2) + 4 * hf + (j & 3)) * 72 + 32 * mt + tok];
                    w.x = o[0] | (o[1] << 16); w.y = o[2] | (o[3] << 16); w.z = o[4] | (o[5] << 16); w.w = o[6] | (o[7] << 16);
                    *(u32x4*)(vdst + ((size_t)(mt * 2 + s) * 64 + lane) * 8) = w; }
            asm volatile("s_waitcnt lgkmcnt(0)" ::: "memory");
        }
    }
    {
        constexpr int PT = 72;
        LAS float* ga = (LAS float*)lds;
        LAS float* bcum = ga + 1024;
        LAS float* tot = bcum + 64 * 256;
        LAS bf16* Qd = (LAS bf16*)(tot + 512);
        LAS bf16* Ki = Qd + 64 * PT; LAS bf16* Ks = Ki + 64 * PT;
        LAS bf16* VT = Ks + 64 * PT;
        LAS bf16* As = VT + 128 * PT;
        bf16* GQD = (bf16*)(a.ws + WS_GQD); bf16* KLOC = (bf16*)(a.ws + WS_KLOC); float* GDEC = (float*)(a.ws + WS_GDEC); const float* rope = (const float*)(a.ws + WS_ROPE);
        const int lr = lane & 15, lq = lane >> 4;
        u32x4 pa, pb, pv0, pv1; unsigned gaw; float cs0[8], cs1[8];
#define GLA1_LOAD(cg_, h_) do { const int t2_ = tid & 255, i_ = t2_ >> 2, part_ = (t2_ >> 1) & 1, c_ = t2_ & 1; \
                const bf16* pr_ = P + ((size_t)64 * (cg_) + i_) * NIN + (tid >= 256 ? 1792 : 1536) + (h_) * 64 + 32 * part_ + 8 * c_; pa = *(const u32x4*)pr_; pb = *(const u32x4*)(pr_ + 16); \
                pv0 = *(const u32x4*)(P + ((size_t)64 * (cg_) + (tid >> 4)) * NIN + 2048 + (h_) * 128 + 8 * (tid & 15)); pv1 = *(const u32x4*)(P + ((size_t)64 * (cg_) + 32 + (tid >> 4)) * NIN + 2048 + (h_) * 128 + 8 * (tid & 15)); } while (0)
#define GLA1_ITEM_LOAD(cg_) do { GLA1_LOAD(cg_, 0); gaw = *(const unsigned*)(P + ((size_t)64 * (cg_) + (tid >> 3)) * NIN + 3072 + (tid & 7) * 2); \
                if ((cg_) < 512) { const int t2_ = tid & 255, i_ = t2_ >> 2, part_ = (t2_ >> 1) & 1, c_ = t2_ & 1; const int t_ = (int)(((size_t)64 * (cg_) + i_) & (SEQ - 1)); const int pos_ = part_ == 0 ? (t_ >> 6) : (t_ & 63); \
                    load8f(rope + (pos_ * 16 + 8 * c_) * 2, cs0); load8f(rope + (pos_ * 16 + 8 * c_) * 2 + 8, cs1); } } while (0)
        const bool gx = (G & 15) == 0; const int gslots = G >> 1;
        const int item0 = gx ? 2 * (((bid >> 4) * 8) + (bid & 7)) + ((bid >> 3) & 1) : bid, istep = gx ? 2 * gslots : G;
        const int d0 = item0 & 1;
        float au[16], ab;
        { const int c = tid & 255;
#pragma unroll
          for (int r = 0; r < 16; ++r) au[r] = a.in[I_GAUP][(d0 * 16 + r) * 256 + c];
          ab = a.in[I_GAB][d0 * 256 + c]; }
        if (item0 < 528 * 2) GLA1_ITEM_LOAD(item0 >> 1);
        for (int rep_ = 0; rep_ < REPS(7); ++rep_)
        for (int item = item0; item < 528 * 2; item += istep) {
            const int cg = item >> 1, d = item & 1; const bool lat = cg < 512;
            bf16* O = (bf16*)(a.ws + (d ? WS_Y1 : WS_Y0));
            if (d != d0) { const int c = tid & 255;
#pragma unroll
                for (int r = 0; r < 16; ++r) au[r] = a.in[I_GAUP][(d * 16 + r) * 256 + c];
                ab = a.in[I_GAB][d * 256 + c]; }
            __syncthreads();
            { const int i = tid >> 3, r2 = (tid & 7) * 2; ga[i * 16 + r2] = bflo(gaw); ga[i * 16 + r2 + 1] = bfhi(gaw); }
            __syncthreads();
            { const int c = tid & 255, hf = tid >> 8; float run = 0.f;
#pragma unroll 4
                for (int ii = 0; ii < 32; ++ii) { const int i = d == 0 ? 32 * hf + ii : 32 * hf + 31 - ii; float x = ab;
#pragma unroll
                    for (int r4 = 0; r4 < 4; ++r4) { const f32x4 gv = *(const LAS f32x4*)(ga + i * 16 + 4 * r4); x += (gv.x * au[4 * r4] + gv.y * au[4 * r4 + 1]) + (gv.z * au[4 * r4 + 2] + gv.w * au[4 * r4 + 3]); }
                    run += logsigmoidf_(x) * (1.0f / 16.0f); bcum[i * 256 + c] = run; }
                tot[hf * 256 + c] = run; }
            __syncthreads();
            { const int c = tid & 255, hf = tid >> 8; const bool mine = d == 0 ? (hf == 1) : (hf == 0); const float off = tot[(d == 0 ? 0 : 1) * 256 + c];
                if (mine) for (int ii = 0; ii < 32; ++ii) bcum[(32 * hf + ii) * 256 + c] += off; }
            if (tid < 256) GDEC[(size_t)(cg * 2 + d) * 256 + tid] = __expf(tot[tid] + tot[256 + tid]);
            for (int h = 0; h < 4; ++h) {
                LDS_BARRIER();
                {
                    const int t2 = tid & 255, i = t2 >> 2, part = (t2 >> 1) & 1, c = t2 & 1; const bool isk = tid >= 256;
                    const size_t m = (size_t)64 * cg + i;
                    float x1[8], x2[8]; unpack8(pa, x1); unpack8(pb, x2);
                    if (lat) {
#pragma unroll
                        for (int e = 0; e < 8; ++e) { const float c_ = e < 4 ? cs0[2 * e] : cs1[2 * e - 8], s_ = e < 4 ? cs0[2 * e + 1] : cs1[2 * e - 7]; const float ya = x1[e] * c_ - x2[e] * s_, yb = x1[e] * s_ + x2[e] * c_; x1[e] = ya; x2[e] = yb; } }
                    const int j1 = 32 * part + 8 * c, j2 = j1 + 16; float b1[8], b2[8];
                    { const LAS float* bp = bcum + i * 256 + h * 64; const f32x4 u0 = *(const LAS f32x4*)(bp + j1), u1 = *(const LAS f32x4*)(bp + j1 + 4), u2 = *(const LAS f32x4*)(bp + j2), u3 = *(const LAS f32x4*)(bp + j2 + 4);
                      b1[0] = u0.x; b1[1] = u0.y; b1[2] = u0.z; b1[3] = u0.w; b1[4] = u1.x; b1[5] = u1.y; b1[6] = u1.z; b1[7] = u1.w; b2[0] = u2.x; b2[1] = u2.y; b2[2] = u2.z; b2[3] = u2.w; b2[4] = u3.x; b2[5] = u3.y; b2[6] = u3.z; b2[7] = u3.w; }
                    if (!isk) { float o1[8], o2[8];
#pragma unroll
                        for (int e = 0; e < 8; ++e) { o1[e] = x1[e] * 0.125f * __expf(b1[e]); o2[e] = x2[e] * 0.125f * __expf(b2[e]); }
                        *(LAS u32x4*)(Qd + i * PT + j1) = pack8(o1); *(LAS u32x4*)(Qd + i * PT + j2) = pack8(o2);
                    } else { float o1[8], o2[8];
#pragma unroll
                        for (int e = 0; e < 8; ++e) { o1[e] = x1[e] * __expf(-b1[e]); o2[e] = x2[e] * __expf(-b2[e]); }
                        *(LAS u32x4*)(Ki + i * PT + j1) = pack8(o1); *(LAS u32x4*)(Ki + i * PT + j2) = pack8(o2);
#pragma unroll
                        for (int e0 = 0; e0 < 8; ++e0) { const int e = (e0 + 2 * (2 * part + c)) & 7;
                            const float bC1 = tot[h * 64 + j1 + e] + tot[256 + h * 64 + j1 + e], bC2 = tot[h * 64 + j2 + e] + tot[256 + h * 64 + j2 + e];
                            float xa = x1[0], xb = x2[0], ba = b1[0], bb = b2[0];
#pragma unroll
                            for (int q = 1; q < 8; ++q) { xa = (e == q) ? x1[q] : xa; xb = (e == q) ? x2[q] : xb; ba = (e == q) ? b1[q] : ba; bb = (e == q) ? b2[q] : bb; }
                            Ks[(j1 + e) * PT + i] = (bf16)f2bf(xa * __expf(bC1 - ba)); Ks[(j2 + e) * PT + i] = (bf16)f2bf(xb * __expf(bC2 - bb)); }
                    }
#pragma unroll
                    for (int rep = 0; rep < 2; ++rep) { const int vi = tid + 512 * rep, tk = vi >> 4, dg = vi & 15; const u32x4 w = rep == 0 ? pv0 : pv1;
                        const unsigned wv[4] = {w.x, w.y, w.z, w.w};
#pragma unroll
                        for (int q = 0; q < 8; ++q) { const int qq = (q + dg) & 7; const unsigned ww = (qq & 4) ? ((qq & 2) ? w.w : w.z) : ((qq & 2) ? w.y : w.x); (void)wv;
                            VT[(8 * dg + qq) * PT + tk] = (bf16)((qq & 1) ? (ww >> 16) : (ww & 0xffffu)); } }
                }
                if (h + 1 < 4) GLA1_LOAD(cg, h + 1); else if (item + istep < 528 * 2) GLA1_ITEM_LOAD((item + istep) >> 1);
                LDS_BARRIER();
                const size_t tile = (size_t)(cg * 2 + d) * 4 + h;
                if (lat) {
#pragma unroll
                    for (int tt = 0; tt < 2; ++tt) {
                        const int tl = 2 * wave + tt, mi = tl >> 2, nj = tl & 3;
                        f32x4 acc = (f32x4){0.f, 0.f, 0.f, 0.f};
                        const bool dead = d == 0 ? (nj > mi) : (nj < mi);
                        if (!dead) {
#pragma unroll
                            for (int ks = 0; ks < 2; ++ks) acc = mfma16(*(const LAS bf16x8*)(Qd + (16 * mi + lr) * PT + 32 * ks + 8 * lq), *(const LAS bf16x8*)(Ki + (16 * nj + lr) * PT + 32 * ks + 8 * lq), acc);
                        }
#pragma unroll
                        for (int rg = 0; rg < 4; ++rg) { const int i = 16 * mi + 4 * lq + rg, j = 16 * nj + lr; const bool keep = d == 0 ? (j <= i) : (j >= i); As[i * PT + j] = (bf16)f2bf(keep ? acc[rg] : 0.f); }
                    }
                    *((u32x4*)(GQD + tile * 4096) + tid) = *(const LAS u32x4*)(Qd + (tid >> 3) * PT + 8 * (tid & 7));
                }
#pragma unroll
                for (int mt = 0; mt < 4; ++mt) { f32x4 acc = (f32x4){0.f, 0.f, 0.f, 0.f};
#pragma unroll
                    for (int ks = 0; ks < 2; ++ks) acc = mfma16(*(const LAS bf16x8*)(Ks + (16 * mt + lr) * PT + 32 * ks + 8 * lq), *(const LAS bf16x8*)(VT + (16 * wave + lr) * PT + 32 * ks + 8 * lq), acc);
                    u32x2 w; w.x = pk2(acc[0], acc[1]); w.y = pk2(acc[2], acc[3]);
                    *(u32x2*)(KLOC + tile * 8192 + (16 * wave + lr) * 64 + 16 * mt + 4 * lq) = w; }
                if (lat) {
                    LDS_BARRIER();
#pragma unroll
                    for (int ni = 0; ni < 4; ++ni) { f32x4 acc = (f32x4){0.f, 0.f, 0.f, 0.f};
#pragma unroll
                        for (int ks = 0; ks < 2; ++ks) acc = mfma16(*(const LAS bf16x8*)(VT + (16 * wave + lr) * PT + 32 * ks + 8 * lq), *(const LAS bf16x8*)(As + (16 * ni + lr) * PT + 32 * ks + 8 * lq), acc);
                        u32x2 w; w.x = pk2(acc[0], acc[1]); w.y = pk2(acc[2], acc[3]);
                        *(u32x2*)(O + ((size_t)64 * cg + 16 * ni + lr) * 512 + h * 128 + 16 * wave + 4 * lq) = w; }
                }
            }
        }
    }
}

#undef GLA1_LOAD
#undef GLA1_ITEM_LOAD
__device__ __forceinline__ void ph_gla_scan(CArgs& a, int tid) {
    const bf16* KLOC = (const bf16*)(a.ws + WS_KLOC); const float* GDEC = (const float*)(a.ws + WS_GDEC); bf16* GST = (bf16*)(a.ws + WS_GST);
    for (int gid = blockIdx.x * NTHREADS + tid; gid < 32 * 4096; gid += gridDim.x * NTHREADS) {
        const int sq = gid >> 12, e2 = gid & 4095, b = sq >> 3, d = (sq >> 2) & 1, h = sq & 3, dk = 2 * (e2 & 31);
        float S0 = 0.f, S1 = 0.f;
#pragma unroll 1
        for (int n0 = 0; n0 < 132; n0 += 6) {
            unsigned kl[6]; f32x2 dc[6];
#pragma unroll
            for (int u = 0; u < 6; ++u) { const int cg = GLA_CG(n0 + u); const size_t tile = (size_t)(cg * 2 + d) * 4 + h; kl[u] = *(const unsigned*)(KLOC + tile * 8192 + 2 * e2); dc[u] = *(const f32x2*)(GDEC + (size_t)(cg * 2 + d) * 256 + h * 64 + dk); }
#pragma unroll
            for (int u = 0; u < 6; ++u) { const int n = n0 + u; const int cg = GLA_CG(n);
                if (n >= 4) *(unsigned*)(GST + ((size_t)(cg * 2 + d) * 4 + h) * 8192 + 2 * e2) = pk2(S0, S1);
                S0 = S0 * dc[u].x + bflo(kl[u]); S1 = S1 * dc[u].y + bfhi(kl[u]); }
        }
    }
}

__device__ __forceinline__ void ph_nat_task(CArgs& a, const LAS float* rpb, float m2, int b, int h, int r, int qt, int lane) {
    const bf16x8* QF = (const bf16x8*)(a.ws + WS_QF); const bf16x8* KF = (const bf16x8*)(a.ws + WS_KF); const bf16x8* VF = (const bf16x8*)(a.ws + WS_VF);
    bf16* ACT = (bf16*)(a.ws + WS_ACT);
    const int hf = lane >> 5, ql = lane & 31;
    const int rs = min(max(r - 4, 0), 120);
#define NAT_KC(ch_) ((ch_) < 16 ? 2 * (rs + ((ch_) >> 1)) + ((ch_) & 1) : 256 + ((ch_) - 16))
#define NAT_LOAD(ch_) do { const size_t kb_ = (size_t)((b * 8 + h) * 264 + NAT_KC(ch_)) * 4 * 64; \
        _Pragma("unroll") for (int s = 0; s < 4; ++s) kfn[s] = KF[kb_ + s * 64 + lane]; \
        _Pragma("unroll") for (int mt = 0; mt < 2; ++mt) _Pragma("unroll") for (int s = 0; s < 2; ++s) vfn[mt][s] = VF[kb_ + (mt * 2 + s) * 64 + lane]; } while (0)
    {
        bf16x8 qf[4];
#pragma unroll
        for (int s = 0; s < 4; ++s) qf[s] = QF[((size_t)((b * 8 + h) * 256 + 2 * r + qt) * 4 + s) * 64 + lane];
        f32x16 Oa[2]; float lrun = 0.f;
#pragma unroll
        for (int mt = 0; mt < 2; ++mt)
#pragma unroll
            for (int i = 0; i < 16; ++i) Oa[mt][i] = 0.f;
        const int c = 32 * qt + ql, cs = min(max(c - 8, 0), 48);
        unsigned vmask[2]; int dcb[2];
#pragma unroll
        for (int hc2 = 0; hc2 < 2; ++hc2) { unsigned mk = 0u;
#pragma unroll
            for (int rg = 0; rg < 16; ++rg) { const int kcol = 32 * hc2 + (rg & 3) + 8 * (rg >> 2) + 4 * hf; mk |= (kcol >= cs && kcol < cs + 16) ? (1u << rg) : 0u; }
            vmask[hc2] = mk; dcb[hc2] = 32 * hc2 + 4 * hf - c + 15; }
        bf16x8 kfn[4], vfn[2][2], kfm[4], vfm[2][2];
#define NAT_LOAD2(ch_) do { const size_t kb_ = (size_t)((b * 8 + h) * 264 + NAT_KC(ch_)) * 4 * 64; \
        _Pragma("unroll") for (int s = 0; s < 4; ++s) kfm[s] = KF[kb_ + s * 64 + lane]; \
        _Pragma("unroll") for (int mt = 0; mt < 2; ++mt) _Pragma("unroll") for (int s = 0; s < 2; ++s) vfm[mt][s] = VF[kb_ + (mt * 2 + s) * 64 + lane]; } while (0)
        NAT_LOAD(0); NAT_LOAD2(1);
        for (int ch = 0; ch < 24; ++ch) {
            const bool local = ch < 16; const int wi = ch >> 1, hc = ch & 1;
            bf16x8 kf[4], vf[2][2];
#pragma unroll
            for (int s = 0; s < 4; ++s) { kf[s] = kfn[s]; kfn[s] = kfm[s]; }
#pragma unroll
            for (int mt = 0; mt < 2; ++mt)
#pragma unroll
                for (int s = 0; s < 2; ++s) { vf[mt][s] = vfn[mt][s]; vfn[mt][s] = vfm[mt][s]; }
            if (ch + 2 < 24) NAT_LOAD2(ch + 2);
            f32x16 S; const float sinit = local ? 0.f : -m2;
#pragma unroll
            for (int i = 0; i < 16; ++i) S[i] = sinit;
#pragma unroll
            for (int s = 0; s < 4; ++s) S = mfma32(kf[s], qf[s], S);
            __builtin_amdgcn_sched_barrier(0);
            float ps = 0.f;
            if (local) {
                const LAS float* bp = rpb + (h * 15 + (rs + wi - r + 7)) * 31 + dcb[hc]; const unsigned vm = vmask[hc];
#pragma unroll
                for (int rg = 0; rg < 16; ++rg) { const float p = __builtin_amdgcn_exp2f(S[rg] + bp[(rg & 3) + 8 * (rg >> 2)]);
                    S[rg] = __uint_as_float(__float_as_uint(p) & (unsigned)__builtin_amdgcn_sbfe((int)vm, rg, 1)); ps += S[rg]; }
            } else {
#pragma unroll
                for (int rg = 0; rg < 16; ++rg) { S[rg] = __builtin_amdgcn_exp2f(S[rg]); ps += S[rg]; }
            }
            lrun += ps;
            __builtin_amdgcn_sched_barrier(0);
            bf16x8 pf[2];
#pragma unroll
            for (int s = 0; s < 2; ++s) { u32x4 w; w.x = pk2(S[8 * s + 0], S[8 * s + 1]); w.y = pk2(S[8 * s + 2], S[8 * s + 3]); w.z = pk2(S[8 * s + 4], S[8 * s + 5]); w.w = pk2(S[8 * s + 6], S[8 * s + 7]); pf[s] = __builtin_bit_cast(bf16x8, w); }
#pragma unroll
            for (int mt = 0; mt < 2; ++mt)
#pragma unroll
                for (int s = 0; s < 2; ++s) Oa[mt] = mfma32(vf[mt][s], pf[s], Oa[mt]);
        }
        const float l = lrun + __shfl_xor(lrun, 32); const float inv = __builtin_amdgcn_rcpf(l);
        const size_t m = (size_t)b * SEQ + r * 64 + 32 * qt + ql;
#pragma unroll
        for (int mt = 0; mt < 2; ++mt)
#pragma unroll
            for (int g = 0; g < 4; ++g) { u32x2 w; w.x = pk2(Oa[mt][4 * g] * inv, Oa[mt][4 * g + 1] * inv); w.y = pk2(Oa[mt][4 * g + 2] * inv, Oa[mt][4 * g + 3] * inv);
                *(u32x2*)(ACT + m * D + h * 64 + 32 * mt + 8 * g + 4 * hf) = w; }
    }
}
#undef NAT_LOAD
#undef NAT_LOAD2
#undef NAT_KC
__device__ __forceinline__ void ph_nat_gla(CArgs& a, LAS unsigned char* lds, int tid, int wave, int lane) {
    const int G = gridDim.x, bid = blockIdx.x;
    for (int rep_ = 0; rep_ < REPS(8); ++rep_) ph_gla_scan(a, tid);
    LAS float* rpb = (LAS float*)lds; LAS float* red = rpb + 3840;
    __syncthreads();
    float gq = 0.f, gk = 0.f, rb = 0.f;
    if (tid < 64) { gq = fabsf(a.in[I_QNG][tid]); gk = fabsf(a.in[I_KNG][tid]); }
    for (int i = tid; i < 8 * 15 * 31; i += NTHREADS) rb = fmaxf(rb, fabsf(a.in[I_RPB][i]));
#pragma unroll
    for (int o = 1; o < 64; o <<= 1) { gq = fmaxf(gq, __shfl_xor(gq, o)); gk = fmaxf(gk, __shfl_xor(gk, o)); rb = fmaxf(rb, __shfl_xor(rb, o)); }
    if (lane == 0) { red[wave * 3] = gq; red[wave * 3 + 1] = gk; red[wave * 3 + 2] = rb; }
    __syncthreads();
    gq = 0.f; gk = 0.f; rb = 0.f;
#pragma unroll
    for (int w = 0; w < NWAVES; ++w) { gq = fmaxf(gq, red[w * 3]); gk = fmaxf(gk, red[w * 3 + 1]); rb = fmaxf(rb, red[w * 3 + 2]); }
    const float Mb = 8.0f * gq * gk * 1.02f + rb, m2 = Mb * 1.44269504f;
    for (int i = tid; i < 8 * 15 * 31; i += NTHREADS) rpb[i] = (a.in[I_RPB][i] - Mb) * 1.44269504f;
    __syncthreads();
    const int gwn = bid * NWAVES + wave, NW = G * NWAVES;
    LAS unsigned char* tile = lds + 16384 + wave * 8192;
    for (int rep_ = 0; rep_ < REPS(10); ++rep_) if (wave >= 4) moe_convert(a, 1, tile, gwn, NW, lane);
    for (int rep_ = 0; rep_ < REPS(9); ++rep_)
    if (G == 256) {
        const int xcd = bid & 7, j = (bid >> 3) * NWAVES + wave;
        for (int k = 0; k < 4; ++k) { const int bh = xcd + 8 * k; ph_nat_task(a, rpb, m2, bh >> 3, bh & 7, j >> 1, j & 1, lane); }
    } else {
        for (int t = gwn; t < 8192; t += NW) ph_nat_task(a, rpb, m2, t >> 11, (t >> 8) & 7, (t >> 1) & 127, t & 1, lane);
    }
    if (wave < 4) moe_convert(a, 1, tile, gwn, NW, lane);
}

__device__ __forceinline__ void ph_gla_readout(CArgs& a, LAS unsigned char* lds, int tid, int wave, int lane) {
    const bf16* P = (const bf16*)(a.ws + WS_P); const bf16* O0 = (const bf16*)(a.ws + WS_Y0); const bf16* O1 = (const bf16*)(a.ws + WS_Y1); bf16* ACT = (bf16*)(a.ws + WS_ACT);
    const bf16* GQD = (const bf16*)(a.ws + WS_GQD); const bf16* GST = (const bf16*)(a.ws + WS_GST);
    constexpr int PT = 72;
    LAS bf16* Qimg = (LAS bf16*)lds;
    LAS float* part = (LAS float*)(lds + 8 * 64 * PT * 2);
    const int lr = lane & 15, lq = lane >> 4;
    for (int cg = blockIdx.x; cg < 512; cg += gridDim.x) {
        __syncthreads();
        { u32x4 qv[8];
#pragma unroll
          for (int t = 0; t < 8; ++t) qv[t] = *((const u32x4*)(GQD + ((size_t)cg * 8 + t) * 4096) + tid);
#pragma unroll
          for (int t = 0; t < 8; ++t) *(LAS u32x4*)(Qimg + t * 64 * PT + (tid >> 3) * PT + 8 * (tid & 7)) = qv[t]; }
        const int dvb = wave & 3, hs = wave >> 2, dv0 = 32 * dvb + 8 * lq;
        f32x4 acc[2][2][4];
#pragma unroll
        for (int hh = 0; hh < 2; ++hh) { const int h = 2 * hh + hs;
#pragma unroll
            for (int ni = 0; ni < 4; ++ni) { const size_t m = (size_t)64 * cg + 16 * ni + lr; const int col = h * 128 + dv0;
                const u32x4 w0 = __builtin_nontemporal_load((const u32x4*)(O0 + m * 512 + col)), w1 = __builtin_nontemporal_load((const u32x4*)(O1 + m * 512 + col));
                acc[hh][0][ni] = (f32x4){bflo(w0.x) + bflo(w1.x), bfhi(w0.x) + bfhi(w1.x), bflo(w0.y) + bflo(w1.y), bfhi(w0.y) + bfhi(w1.y)};
                acc[hh][1][ni] = (f32x4){bflo(w0.z) + bflo(w1.z), bfhi(w0.z) + bfhi(w1.z), bflo(w0.w) + bflo(w1.w), bfhi(w0.w) + bfhi(w1.w)}; }
        }
        bf16x8 af[2][2][2][2];
#pragma unroll
        for (int hh = 0; hh < 2; ++hh)
#pragma unroll
            for (int tt = 0; tt < 2; ++tt)
#pragma unroll
                for (int d = 0; d < 2; ++d)
#pragma unroll
                    for (int ks = 0; ks < 2; ++ks) af[hh][tt][d][ks] = __builtin_nontemporal_load((const bf16x8*)(GST + ((size_t)(cg * 2 + d) * 4 + 2 * hh + hs) * 8192 + (32 * dvb + 8 * (lr >> 2) + 4 * tt + (lr & 3)) * 64 + 32 * ks + 8 * lq));
        __syncthreads();
#pragma unroll
        for (int hh = 0; hh < 2; ++hh)
#pragma unroll
            for (int d = 0; d < 2; ++d) { const LAS bf16* Qt = Qimg + (d * 4 + 2 * hh + hs) * 64 * PT;
#pragma unroll
                for (int ni = 0; ni < 4; ++ni)
#pragma unroll
                    for (int ks = 0; ks < 2; ++ks) { const bf16x8 qb = *(const LAS bf16x8*)(Qt + (16 * ni + lr) * PT + 32 * ks + 8 * lq);
                        acc[hh][0][ni] = mfma16(af[hh][0][d][ks], qb, acc[hh][0][ni]); acc[hh][1][ni] = mfma16(af[hh][1][d][ks], qb, acc[hh][1][ni]); }
            }
        __syncthreads();
#pragma unroll
        for (int hh = 0; hh < 2; ++hh)
#pragma unroll
            for (int ni = 0; ni < 4; ++ni) { float ss = 0.f;
#pragma unroll
                for (int tt = 0; tt < 2; ++tt) ss += acc[hh][tt][ni][0] * acc[hh][tt][ni][0] + acc[hh][tt][ni][1] * acc[hh][tt][ni][1] + acc[hh][tt][ni][2] * acc[hh][tt][ni][2] + acc[hh][tt][ni][3] * acc[hh][tt][ni][3];
                ss += __shfl_xor(ss, 16); ss += __shfl_xor(ss, 32);
                if (lq == 0) part[(dvb * 4 + 2 * hh + hs) * 64 + 16 * ni + lr] = ss; }
        __syncthreads();
        float lg8[8]; load8f(a.in[I_GLNG] + dv0, lg8);
#pragma unroll
        for (int hh = 0; hh < 2; ++hh) { const int h = 2 * hh + hs;
#pragma unroll
            for (int ni = 0; ni < 4; ++ni) { const int i = 16 * ni + lr; float ss = 0.f;
#pragma unroll
                for (int w = 0; w < 4; ++w) ss += part[(w * 4 + h) * 64 + i];
                const float rstd = rsqrtf(ss * (1.0f / 128.0f) + 1e-6f);
                const size_t m = (size_t)64 * cg + i; float g[8]; unpack8(__builtin_nontemporal_load((const u32x4*)(P + m * NIN + 2560 + h * 128 + dv0)), g);
                float o[8];
#pragma unroll
                for (int e = 0; e < 8; ++e) o[e] = acc[hh][e >> 2][ni][e & 3] * rstd * lg8[e] * (g[e] * sigmoidf_(g[e]));
                *(u32x4*)(ACT + m * D + 512 + h * 128 + dv0) = pack8(o); }
        }
    }
}

constexpr int NPH = 25;
__global__ void __launch_bounds__(NTHREADS) fwd_megakernel(Args a_) {
    extern __shared__ __attribute__((aligned(16))) unsigned char lds_raw[];
    LAS unsigned char* lds = (LAS unsigned char*)lds_raw;
    const int tid = threadIdx.x, lane = tid & 63, wave = __builtin_amdgcn_readfirstlane(tid >> 6);
    const int G = gridDim.x, bid = blockIdx.x;
#if MK_XCDBAR
    volatile LAS unsigned* MISC = (volatile LAS unsigned*)(lds + MISC_OFF);
    if (tid < 64) MISC[tid] = 0u;
    __syncthreads();
    XcdBarrier xbar = xcd_barrier_post((unsigned*)(a_.ws + WS_CTL) + 1024, MISC + 8);
#define GRID_BAR() xcd_barrier(xbar)
#else
    cg::grid_group grid = cg::this_grid();
#define GRID_BAR() grid.sync()
#endif
    const int lo = a_.ph_lo, hi = a_.ph_hi;
#ifdef ONLY_PH
#define IN(k) ((k) == ONLY_PH && lo <= (k) && (k) < hi)
#else
#define IN(k) (lo <= (k) && (k) < hi)
#endif
#define SEAM(k) do { if (IN(k) && IN((k) + 1)) GRID_BAR(); } while (0)
    CArgs* const kp = (CArgs*)__builtin_amdgcn_kernarg_segment_ptr();
#define PHASE(k, ...) do { if (IN(k)) { CArgs* ap_ = kp; asm volatile("" : "+s"(ap_)); CArgs& a = *ap_; \
        __VA_ARGS__ } } while (0)
#define WS(off) (a.ws + (off))
    pg8::StaticOrder S;

    PHASE(0, ph_prologue(a, lds, tid, wave, lane););
    SEAM(0);
    PHASE(1, ph_norm1_l0(a, wave, lane););
    SEAM(1);
    PHASE(2, pg8::Gemm g{(const bf16*)WS(WS_ACT), (const bf16*)WS(WS_WIN0), D, D, D, 1 << 30, 0, nullptr, -1}; S.init(MT / 256, NIN / 256, G, bid);
        pg8::EpiInproj0 E{(bf16*)WS(WS_P), LDP0}; pg8::gemm_phase(lds, g, S, E););
    SEAM(2);
    PHASE(3, pg8::Gemm g{(const bf16*)WS(WS_P) + 2688, (const bf16*)WS(WS_WB2T) + (size_t)2048 * 256 + 128, LDP0, 256, 128, 1 << 30, 0, nullptr, -1}; S.init(MT / 256, 2, G, bid);
        pg8::EpiBf16<0> E{(bf16*)WS(WS_Q2), 512, nullptr}; pg8::gemm_phase(lds, g, S, E););
    if (IN(3) && IN(4)) __syncthreads();
    PHASE(4, ph_rwkv_prep(a, lds, tid, wave, lane););
    SEAM(4);
    PHASE(5, ph_rwkv_seq(a, lds, tid, wave, lane););
    SEAM(5);
    PHASE(6, ph_rwkv_readout(a, wave, lane););
    SEAM(6);
    PHASE(7, pg8::Gemm g{(const bf16*)WS(WS_ACT), (const bf16*)WS(WS_WOUT0), D, D, D, 1 << 30, 0, nullptr, -1};
        pg8::TailOrder T; T.init(ML / 256, 4, G, bid, 0, 1 << 30, 0, MC / 256, ML / 256, 1, 4, D / 4);
        pg8::EpiResid<false> E{a.in[I_X], (bf16*)a.out, (const float*)WS(WS_MOD) + 2048, (float*)WS(WS_XPC)}; pg8::gemm_phase<pg8::EpiResid<false>, false, pg8::TailOrder>(lds, g, T, E););
    SEAM(7);
    PHASE(8, ph_norm2_router(a, 0, MT, lds, tid, wave, lane););
    SEAM(8);
    PHASE(9, ph_topk(a, 0, lds, tid, wave, lane););
    SEAM(9);
    PHASE(11, pg8::Gemm g{(const bf16*)WS(WS_ACT), (const bf16*)WS(WS_W13T), D, D, D, RPE0 / 256, (size_t)3072 * D, (const int*)WS(WS_IDX), 16}; S.init(NE * RPE0 / 256, 3072 / 256, G, bid);
        pg8::EpiSwiglu E{(bf16*)WS(WS_P), DE}; pg8::gemm_phase<pg8::EpiSwiglu, true>(lds, g, S, E););
    SEAM(11);
    PHASE(12, pg8::Gemm g{(const bf16*)WS(WS_P), (const bf16*)WS(WS_W2T), DE, DE, DE, RPE0 / 256, (size_t)D * DE, nullptr, 16};
        pg8::TailOrder T; T.init(NE * 16, 4, G, bid, 1, 16, 17, NE, 16, 17, 4, DE / 4);
        pg8::EpiDown E{(bf16*)WS(WS_Q2), (bf16*)WS(WS_YEC)}; pg8::gemm_phase<pg8::EpiDown, false, pg8::TailOrder>(lds, g, T, E););
    SEAM(12);
    PHASE(13, ph_combine<true>(a, 0, MT, wave, lane););
    SEAM(13);
    PHASE(14, pg8::Gemm g{(const bf16*)WS(WS_ACT), (const bf16*)WS(WS_WIN1), D, D, D, 1 << 30, 0, nullptr, -1}; S.init(MT / 256, NIN / 256, G, bid);
        pg8::EpiBf16<0> E{(bf16*)WS(WS_P), NIN, nullptr}; pg8::gemm_phase(lds, g, S, E););
    SEAM(14);
    PHASE(15, ph_l1_prep(a, lds, tid, wave, lane););
    SEAM(15);
    PHASE(16, ph_nat_gla(a, lds, tid, wave, lane););
    SEAM(16);
    PHASE(17, ph_gla_readout(a, lds, tid, wave, lane););
    SEAM(17);
    PHASE(18, pg8::Gemm g{(const bf16*)WS(WS_ACT), (const bf16*)WS(WS_WOUT1), D, D, D, 1 << 30, 0, nullptr, -1}; S.init(ML / 256, D / 256, G, bid);
        pg8::EpiResid<true> E{a.out, (bf16*)a.out, (const float*)WS(WS_MOD) + 5 * 6144 + 2048, nullptr}; pg8::gemm_phase(lds, g, S, E););
    SEAM(18);
    PHASE(19, ph_norm2_router(a, 1, ML, lds, tid, wave, lane););
    SEAM(19);
    PHASE(20, ph_topk(a, 1, lds, tid, wave, lane););
    SEAM(20);
    PHASE(22, pg8::Gemm g{(const bf16*)WS(WS_ACT), (const bf16*)WS(WS_W13T), D, D, D, RPE1 / 256, (size_t)3072 * D, (const int*)WS(WS_IDX), -1}; S.init(NE * RPE1 / 256, 3072 / 256, G, bid);
        pg8::EpiSwiglu E{(bf16*)WS(WS_P), DE}; pg8::gemm_phase<pg8::EpiSwiglu, true>(lds, g, S, E););
    SEAM(22);
    PHASE(23, pg8::Gemm g{(const bf16*)WS(WS_P), (const bf16*)WS(WS_W2T), DE, DE, DE, RPE1 / 256, (size_t)D * DE, nullptr, -1}; S.init(NE * RPE1 / 256, D / 256, G, bid, 1);
        pg8::EpiBf16<0> E{(bf16*)WS(WS_Q2), D, nullptr}; pg8::gemm_phase(lds, g, S, E););
    SEAM(23);
    PHASE(24, ph_combine<false>(a, 1, ML, wave, lane););
#undef PHASE
#undef WS
#undef IN
#undef SEAM
}

extern "C" void kernel_launch(void* const* d_in, const int* in_sizes, int n_in, void* d_out, int out_size, void* d_ws, size_t ws_size, hipStream_t stream) {
    static int grid = 0;
    if (grid == 0) {
        if (n_in != 33 || out_size != ML * D || ws_size < WS_NEED) { fprintf(stderr, "kernel_launch: unexpected problem (n_in %d, out %d, ws %zu < %zu); nothing launched\n", n_in, out_size, ws_size, (size_t)WS_END); grid = -1; return; }
        int dev = 0, cus = 0, per_cu = 0;
        if (hipGetDevice(&dev) != hipSuccess || hipDeviceGetAttribute(&cus, hipDeviceAttributeMultiprocessorCount, dev) != hipSuccess) { grid = -1; return; }
        if (hipFuncSetAttribute((const void*)fwd_megakernel, hipFuncAttributeMaxDynamicSharedMemorySize, LDS_BYTES) != hipSuccess) { fprintf(stderr, "kernel_launch: hipFuncSetAttribute failed\n"); grid = -1; return; }
        if (hipOccupancyMaxActiveBlocksPerMultiprocessor(&per_cu, (const void*)fwd_megakernel, NTHREADS, LDS_BYTES) != hipSuccess || per_cu < 1) { fprintf(stderr, "kernel_launch: occupancy query says %d blocks per CU\n", per_cu); per_cu = 1; }
        (void)hipGetLastError();
        if (cus < 16 || (cus & 15)) { fprintf(stderr, "kernel_launch: the rwkv prep phase expects a multiple of 16 CUs (got %d)\n", cus); grid = -1; return; }
        grid = cus;
    }
    if (grid < 0) return;
    (void)hipMemsetAsync((char*)d_ws + WS_CTL, 0, CTL_ZERO_BYTES, stream);
    Args a{};
    for (int i = 0; i < 33; ++i) a.in[i] = (const float*)d_in[i];
    a.out = (float*)d_out; a.ws = (unsigned char*)d_ws;
#if MK_MULTI
    for (int ph = 0; ph < NPH; ++ph) { a.ph_lo = ph; a.ph_hi = ph + 1; const int reps = ((MK_REPEAT_MASK >> ph) & 1) ? 2 : 1;
        for (int r = 0; r < reps; ++r) hipLaunchKernelGGL(fwd_megakernel, dim3(grid), dim3(NTHREADS), LDS_BYTES, stream, a); }
#else
    a.ph_lo = 0; a.ph_hi = NPH;
    void* args[] = {&a};
    hipError_t e = hipLaunchCooperativeKernel((const void*)fwd_megakernel, dim3(grid), dim3(NTHREADS), args, LDS_BYTES, stream);
    if (e != hipSuccess) fprintf(stderr, "kernel_launch: cooperative launch failed: %s (grid %d)\n", hipGetErrorString(e), grid);
#endif
}
```
